# Optimizing an MI355X kernel written in HIP

```python
import jax, jax.numpy as jnp
from jax import lax
import numpy as np

D_MODEL = 1024
BATCH = 4
SEQ = 8192
DEPTH = 1

HEAD_DIM = 64
N_HEADS = D_MODEL // HEAD_DIM
N_HEADS_A = 10
N_KV_A = 2
N_HEADS_B = N_HEADS - N_HEADS_A
D_MIX = N_HEADS * HEAD_DIM
N_IDX_HEADS = 8
IDX_DIM = 64
TOPK_MAX = 256
QBLOCK = 128
DILATED_PATTERNS = ((128, 1), (512, 4), (2048, 16))
ROPE_THETA = 10000.0
EPS = 1e-6

SPLIT_SIZES = (
    N_HEADS_A * HEAD_DIM,
    N_KV_A * HEAD_DIM,
    N_KV_A * HEAD_DIM,
    N_IDX_HEADS * IDX_DIM,
    IDX_DIM,
    N_IDX_HEADS,
    N_HEADS_B * HEAD_DIM,
    N_HEADS_B * HEAD_DIM,
    N_HEADS_B * HEAD_DIM,
)
D_IN = sum(SPLIT_SIZES)
SPLIT_POINTS = tuple(int(v) for v in np.cumsum(SPLIT_SIZES)[:-1])

N_EXPERTS = 256
TOP_K = 8
N_GROUPS = 8
TOPK_GROUPS = 4
D_EXPERT = 256
D_SHARED = 256
ROUTED_SCALE = 2.5
MOE_BLOCK = 256

kernel_name = "hybrid_dsa_dilated_moe_adaln"

f32 = jnp.float32


def rmsnorm(t, g):
    tf = t.astype(f32)
    y = tf * lax.rsqrt(jnp.mean(tf * tf, axis=-1, keepdims=True) + EPS)
    return (y * g.astype(f32)).astype(t.dtype)


def rope(t, pos):
    half = t.shape[-1] // 2
    inv = ROPE_THETA ** (-jnp.arange(half, dtype=f32) / half)
    ang = pos.astype(f32)[..., None] * inv
    cos = jnp.cos(ang)[:, :, None, :]
    sin = jnp.sin(ang)[:, :, None, :]
    tf = t.astype(f32)
    t1, t2 = tf[..., :half], tf[..., half:]
    return jnp.concatenate([t1 * cos - t2 * sin, t2 * cos + t1 * sin], axis=-1).astype(t.dtype)


def sparse_index_attention(q, k, v, q_idx, k_idx, w_idx):
    B, S, HA, hd = q.shape
    n_kv = k.shape[2]
    grp = HA // n_kv
    n_sel = min(TOPK_MAX, S // 4)
    nb = S // QBLOCK
    w_scaled = w_idx.astype(f32) * (N_IDX_HEADS ** -0.5 * IDX_DIM ** -0.5)
    key_index = jnp.arange(S)

    def blocks(t):
        return jnp.moveaxis(t.reshape((B, nb, QBLOCK) + t.shape[2:]), 1, 0)

    def one_block(args):
        qb, qib, wb, bi = args
        qpos = bi * QBLOCK + jnp.arange(QBLOCK)
        causal = key_index[None, :] <= qpos[:, None]
        logits = jnp.einsum('bqhd,bsd->bqhs', qib, k_idx).astype(f32)
        score = jnp.einsum('bqhs,bqh->bqs', jax.nn.relu(logits), wb)
        score = jnp.where(causal[None], score, -jnp.inf)
        _, sel = lax.top_k(score, n_sel)
        valid = sel <= qpos[None, :, None]
        k_sel = jax.vmap(lambda kk, ii: kk[ii])(k, sel)
        v_sel = jax.vmap(lambda vv, ii: vv[ii])(v, sel)
        qg = qb.reshape(B, QBLOCK, n_kv, grp, hd)
        s = jnp.einsum('bqhgd,bqkhd->bqhgk', qg, k_sel).astype(f32) * hd ** -0.5
        s = jnp.where(valid[:, :, None, None, :], s, -jnp.inf)
        p = jax.nn.softmax(s, axis=-1).astype(v.dtype)
        o = jnp.einsum('bqhgk,bqkhd->bqhgd', p, v_sel)
        return o.reshape(B, QBLOCK, HA * hd)

    out = lax.map(one_block, (blocks(q), blocks(q_idx), blocks(w_scaled), jnp.arange(nb)))
    return jnp.moveaxis(out, 0, 1).reshape(B, S, HA * hd)


def dilated_branch(q, k, v, window, dil):
    B, S, H, hd = q.shape
    span = window // dil
    n = S // dil
    nb = -(-n // span)
    n_pad = nb * span

    def to_sub(t):
        t = t.reshape(B, n, dil, H, hd)
        t = jnp.pad(t, ((0, 0), (0, n_pad - n), (0, 0), (0, 0), (0, 0)))
        return t.reshape(B, nb, span, dil, H, hd)

    def with_prev(t):
        prev = jnp.pad(t[:, :-1], ((0, 0), (1, 0), (0, 0), (0, 0), (0, 0), (0, 0)))
        return jnp.concatenate([prev, t], axis=2)

    qs = to_sub(q)
    kw = with_prev(to_sub(k))
    vw = with_prev(to_sub(v))
    s = jnp.einsum('bnqrhd,bnkrhd->bnrhqk', qs, kw).astype(f32) * hd ** -0.5
    qq = jnp.arange(span)[:, None]
    kk = jnp.arange(2 * span)[None, :]
    band = (kk >= qq) & (kk <= qq + span)
    first = jnp.arange(nb)[:, None, None] > 0
    mask = band[None] & (first | (kk >= span)[None])
    s = jnp.where(mask[None, :, None, None], s, -jnp.inf)
    m = jnp.max(s, axis=-1)
    p = jnp.exp(s - m[..., None])
    l = jnp.sum(p, axis=-1)
    num = jnp.einsum('bnrhqk,bnkrhd->bnqrhd', p, vw.astype(f32))
    num = num.reshape(B, n_pad, dil, H, hd)[:, :n].reshape(B, S, H, hd)

    def stats_back(t):
        t = jnp.transpose(t, (0, 1, 4, 2, 3)).reshape(B, n_pad, dil, H)
        return t[:, :n].reshape(B, S, H)

    return num, stats_back(m), stats_back(l)


def dilated_attention(q, k, v):
    B, S, H, hd = q.shape
    branches = [dilated_branch(q, k, v, w, d) for (w, d) in DILATED_PATTERNS]
    m_all = jnp.stack([br[1] for br in branches])
    m_max = jnp.max(m_all, axis=0)
    num = sum(jnp.exp(br[1] - m_max)[..., None] * br[0] for br in branches)
    den = sum(jnp.exp(br[1] - m_max) * br[2] for br in branches)
    return (num / den[..., None]).astype(q.dtype).reshape(B, S, H * hd)


def swiglu(h, wg, wu, wd):
    return (jax.nn.silu(h @ wg) * (h @ wu)) @ wd


def routed_experts(h, w_router, router_bias, w_gate, w_up, w_down):
    N, D = h.shape
    E = w_router.shape[1]
    per_group = E // N_GROUPS
    scores = jax.nn.sigmoid((h @ w_router).astype(f32))
    biased = scores + router_bias.astype(f32)
    grp_score = jnp.sum(lax.top_k(biased.reshape(N, N_GROUPS, per_group), 2)[0], axis=-1)
    _, top_g = lax.top_k(grp_score, TOPK_GROUPS)
    gmask = jnp.any(top_g[:, :, None] == jnp.arange(N_GROUPS)[None, None, :], axis=1)
    allowed = jnp.repeat(gmask, per_group, axis=1)
    _, sel = lax.top_k(jnp.where(allowed, biased, -jnp.inf), TOP_K)
    gate = jnp.take_along_axis(scores, sel, axis=1)
    gate = gate / jnp.sum(gate, axis=-1, keepdims=True) * ROUTED_SCALE

    n_assign = N * TOP_K
    flat_e = sel.reshape(-1)
    flat_tok = jnp.arange(n_assign, dtype=jnp.int32) // TOP_K
    order = jnp.argsort(flat_e)
    e_sorted = flat_e[order]
    counts = jnp.bincount(flat_e, length=E)
    padded = (counts + MOE_BLOCK - 1) // MOE_BLOCK * MOE_BLOCK
    pad_end = jnp.cumsum(padded)
    start = jnp.cumsum(counts) - counts
    slot = (pad_end - padded)[e_sorted] + jnp.arange(n_assign) - start[e_sorted]
    n_blocks = -(-n_assign // MOE_BLOCK) + E
    n_slots = n_blocks * MOE_BLOCK
    slot_tok = jnp.full((n_slots,), N, jnp.int32).at[slot].set(flat_tok[order])
    slot_w = jnp.zeros((n_slots,), f32).at[slot].set(gate.reshape(-1)[order])
    block_start = jnp.arange(n_blocks) * MOE_BLOCK
    block_expert = jnp.minimum(jnp.searchsorted(pad_end, block_start, side='right'), E - 1)
    h_pad = jnp.concatenate([h, jnp.zeros((1, D), h.dtype)], axis=0)

    def expert_block(args):
        tok, w, e = args
        y = swiglu(h_pad[tok], w_gate[e], w_up[e], w_down[e])
        return y.astype(f32) * w[:, None]

    yb = lax.map(expert_block, (slot_tok.reshape(n_blocks, MOE_BLOCK),
                                slot_w.reshape(n_blocks, MOE_BLOCK), block_expert))
    y = jnp.zeros((N + 1, D), f32).at[slot_tok].add(yb.reshape(n_slots, D))
    return y[:N].astype(h.dtype)


def setup_inputs(seed: int = 0) -> dict:
    key = jax.random.key(seed)
    ks = jax.random.split(key, 20)
    L = DEPTH

    def nrm(k, shape, fan_in):
        return jax.random.normal(k, shape, f32) * fan_in ** -0.5

    def gain(k, shape):
        return 1.0 + 0.05 * jax.random.normal(k, shape, f32)

    return {
        "x": jax.random.normal(ks[0], (BATCH, SEQ, D_MODEL), f32),
        "c": jax.random.normal(ks[1], (BATCH, D_MODEL), f32),
        "positions": jnp.tile(jnp.arange(SEQ, dtype=jnp.int32)[None, :], (BATCH, 1)),
        "w_ada": 0.5 * nrm(ks[2], (L, D_MODEL, 6 * D_MODEL), D_MODEL),
        "b_ada": 0.01 * jax.random.normal(ks[3], (L, 6 * D_MODEL), f32),
        "g_mix": gain(ks[4], (L, D_MODEL)),
        "w_in": nrm(ks[5], (L, D_MODEL, D_IN), D_MODEL),
        "q_norm_a": gain(ks[6], (L, HEAD_DIM)),
        "k_norm_a": gain(ks[7], (L, HEAD_DIM)),
        "q_norm_b": gain(ks[8], (L, HEAD_DIM)),
        "k_norm_b": gain(ks[9], (L, HEAD_DIM)),
        "w_out": nrm(ks[10], (L, D_MIX, D_MODEL), D_MIX),
        "g_ffn": gain(ks[11], (L, D_MODEL)),
        "w_router": nrm(ks[12], (L, D_MODEL, N_EXPERTS), D_MODEL),
        "router_bias": 0.01 * jax.random.normal(ks[13], (L, N_EXPERTS), f32),
        "w_gate": nrm(ks[14], (L, N_EXPERTS, D_MODEL, D_EXPERT), D_MODEL),
        "w_up": nrm(ks[15], (L, N_EXPERTS, D_MODEL, D_EXPERT), D_MODEL),
        "w_down": nrm(ks[16], (L, N_EXPERTS, D_EXPERT, D_MODEL), D_EXPERT),
        "ws_gate": nrm(ks[17], (L, D_MODEL, D_SHARED), D_MODEL),
        "ws_up": nrm(ks[18], (L, D_MODEL, D_SHARED), D_MODEL),
        "ws_down": nrm(ks[19], (L, D_SHARED, D_MODEL), D_SHARED),
    }


def reference(x, c, positions, w_ada, b_ada, g_mix, w_in, q_norm_a, k_norm_a, q_norm_b, k_norm_b,
              w_out, g_ffn, w_router, router_bias, w_gate, w_up, w_down, ws_gate, ws_up, ws_down):
    B, S, D = x.shape
    for l in range(DEPTH):
        mod = (jax.nn.silu(c) @ w_ada[l] + b_ada[l])[:, None, :]
        sh_a, sc_a, gt_a, sh_f, sc_f, gt_f = jnp.split(mod, 6, axis=-1)

        h = rmsnorm(x, g_mix[l]) * (1.0 + sc_a) + sh_a
        proj = h @ w_in[l]
        qa, ka, va, qi, ki, wi, qb, kb, vb = jnp.split(proj, SPLIT_POINTS, axis=-1)
        qa = rope(rmsnorm(qa.reshape(B, S, N_HEADS_A, HEAD_DIM), q_norm_a[l]), positions)
        ka = rope(rmsnorm(ka.reshape(B, S, N_KV_A, HEAD_DIM), k_norm_a[l]), positions)
        va = va.reshape(B, S, N_KV_A, HEAD_DIM)
        qi = rope(qi.reshape(B, S, N_IDX_HEADS, IDX_DIM), positions)
        ki = rope(ki[:, :, None, :], positions)[:, :, 0, :]
        qb = rope(rmsnorm(qb.reshape(B, S, N_HEADS_B, HEAD_DIM), q_norm_b[l]), positions)
        kb = rope(rmsnorm(kb.reshape(B, S, N_HEADS_B, HEAD_DIM), k_norm_b[l]), positions)
        vb = vb.reshape(B, S, N_HEADS_B, HEAD_DIM)

        o_a = sparse_index_attention(qa, ka, va, qi, ki, wi)
        o_b = dilated_attention(qb, kb, vb)
        mix = jnp.concatenate([o_a, o_b], axis=-1) @ w_out[l]
        x = x + gt_a * mix

        h = (rmsnorm(x, g_ffn[l]) * (1.0 + sc_f) + sh_f).reshape(B * S, D)
        ffn = swiglu(h, ws_gate[l], ws_up[l], ws_down[l]) + routed_experts(
            h, w_router[l], router_bias[l], w_gate[l], w_up[l], w_down[l])
        x = x + gt_f * ffn.reshape(B, S, D)
    return x
```

```cpp
#include <hip/hip_runtime.h>
#include <hip/hip_cooperative_groups.h>
#include <stdint.h>
#include <stdio.h>
namespace cg = cooperative_groups;

typedef unsigned short u16;
typedef unsigned int u32;
typedef unsigned long long u64;
typedef __attribute__((ext_vector_type(8))) short bf16x8;
typedef __attribute__((ext_vector_type(4))) short s16x4;
typedef __attribute__((ext_vector_type(4))) float f32x4;
typedef __attribute__((ext_vector_type(16))) float f32x16;
typedef __attribute__((ext_vector_type(2))) float f32x2;
typedef __attribute__((ext_vector_type(4))) u32 u32x4;
typedef __attribute__((ext_vector_type(2))) u32 u32x2;
typedef __attribute__((ext_vector_type(2))) __bf16 bf16x2_t;
#define DI __device__ __forceinline__
#define LDS_AS __attribute__((address_space(3)))

#ifndef MEGA
#define MEGA 1
#endif
#ifndef DEBUG_MODE
#define DEBUG_MODE 0
#endif
#define DBG_TMOD 0
#define DBG_SUB 0
#define DBG_BUF 8
#define DBG_X1 2
#define DBG_X2 1
constexpr int NB_ = 4, S_ = 8192, D_ = 1024, NTOK = NB_ * S_;
constexpr int DIN_PAD = 2688;
constexpr int NEXP = 256, TOPK = 8, DEXP = 256;
constexpr int NSLOT = NTOK * TOPK;
constexpr float EPS_ = 1e-6f;
constexpr int NSEL = 256;
constexpr int THREADS = 256;
constexpr int SMEM_BYTES = 78336;

constexpr size_t al256(size_t x) { return (x + 255) & ~size_t(255); }
constexpr size_t O_CNT = 0;
constexpr size_t O_KMAX = 1024;
constexpr size_t O_DBG = 2048;
constexpr size_t O_BAR = 4096;
constexpr size_t ZERO_BYTES = 32768;
constexpr size_t O_MOD = 32768;
constexpr size_t O_WT_IN = O_MOD + al256(4 * 6144 * 4);
constexpr size_t O_WT_OUT = O_WT_IN + (size_t)DIN_PAD * 1024 * 2;
constexpr size_t O_WT_RT = O_WT_OUT + (size_t)1024 * 1024 * 2;
constexpr size_t O_WT_SGU = O_WT_RT + (size_t)256 * 3072 * 2;
constexpr size_t O_WT_SD = O_WT_SGU + (size_t)512 * 1024 * 2;
constexpr size_t O_ROPE = O_WT_SD + (size_t)1024 * 256 * 2;
constexpr size_t O_SELE = O_ROPE + (size_t)NTOK * 32 * 8;
constexpr size_t O_GATE = O_SELE + (size_t)NTOK * 8 * 4;
constexpr size_t O_POSE = O_GATE + (size_t)NTOK * 8 * 4;
constexpr size_t O_TOKSLOT = O_POSE + (size_t)NTOK * 8 * 4;
constexpr size_t O_SLOTTOK = O_TOKSLOT + (size_t)NTOK * 8 * 4;
constexpr size_t O_SLOTGATE = O_SLOTTOK + (size_t)NSLOT * 4;
constexpr size_t O_SELCNT = O_SLOTGATE + (size_t)NSLOT * 4;
constexpr size_t O_LOGITS = O_SELCNT + (size_t)NTOK * 4;
constexpr size_t O_ACTS = O_LOGITS + (size_t)NTOK * 256 * 4;
constexpr size_t O_WT_ED = O_ACTS + (size_t)NTOK * 256 * 2;
constexpr size_t O_O = O_WT_ED + (size_t)NEXP * 1024 * 256 * 2;
constexpr size_t O_DNUM = O_O + (size_t)NTOK * 1024 * 2;
constexpr size_t O_DML = O_DNUM + (size_t)3 * NTOK * 384 * 2;
constexpr size_t O_ACT = O_DML + (size_t)3 * NTOK * 6 * 2 * 4;
constexpr size_t O_QB = O_ACT;
constexpr size_t O_KB = O_QB + (size_t)NTOK * 384 * 2;
constexpr size_t O_VB = O_KB + (size_t)NTOK * 384 * 2;
constexpr size_t O_SEL = O_VB + (size_t)NTOK * 384 * 2;
constexpr size_t O_BIG = O_ACT + (size_t)NSLOT * 256 * 2;
constexpr size_t O_WT_EGU = O_BIG;
constexpr size_t O_H = O_WT_EGU + (size_t)NEXP * 512 * 1024 * 2;
constexpr size_t O_QA = O_H + (size_t)NTOK * 2048 * 2;
constexpr size_t O_KV = O_QA + (size_t)NTOK * 640 * 2;
constexpr size_t O_QI = O_KV + (size_t)NTOK * 256 * 2;
constexpr size_t O_KI = O_QI + (size_t)NTOK * 512 * 2;
constexpr size_t O_WI = O_KI + (size_t)NTOK * 64 * 2;
constexpr size_t O_BIG_USED = O_WI + (size_t)NTOK * 8 * 4;
constexpr size_t WS_TOTAL = O_BIG + (size_t)NSLOT * 1024 * 2;
static_assert(O_BIG_USED <= WS_TOTAL, "overlay too large");
static_assert(O_SEL + (size_t)NTOK * 256 * 2 <= O_BIG, "act overlay too large");

struct Params {
  const float *x, *c; const int* pos;
  const float *w_ada, *b_ada, *g_mix, *w_in, *qna, *kna, *qnb, *knb, *w_out, *g_ffn, *w_router, *rbias,
              *w_gate, *w_up, *w_down, *ws_gate, *ws_up, *ws_down;
  float* out; char* ws;
};

DI int fresh_tid() { int t = threadIdx.x; asm volatile("" : "+v"(t)); return t; }
DI float bf2f(u16 h) { return __uint_as_float(((u32)h) << 16); }
DI u16 f2bf(float f) { return __builtin_bit_cast(u16, (__bf16)f); }
DI u32 pack2(float a, float b) { f32x2 v = {a, b}; return __builtin_bit_cast(u32, __builtin_convertvector(v, bf16x2_t)); }
DI bf16x8 pack8(float a0, float a1, float a2, float a3, float a4, float a5, float a6, float a7) {
  u32x4 p = {pack2(a0, a1), pack2(a2, a3), pack2(a4, a5), pack2(a6, a7)};
  return __builtin_bit_cast(bf16x8, p);
}
DI float wave_sum(float v) { for (int o = 32; o > 0; o >>= 1) v += __shfl_xor(v, o); return v; }
#define DPP_ADD(v, ctrl) ((v) + __builtin_bit_cast(float, __builtin_amdgcn_update_dpp(0, __builtin_bit_cast(int, (v)), (ctrl), 0xf, 0xf, true)))
DI float row16_sum(float v) {
  v = DPP_ADD(v, 0xB1);
  v = DPP_ADD(v, 0x4E);
  v = DPP_ADD(v, 0x141);
  v = DPP_ADD(v, 0x140);
  return v;
}
DI float silu_f(float v) { return v / (1.f + __expf(-v)); }
DI float sigmoid_f(float v) { return 1.f / (1.f + __expf(-v)); }
DI void glds16(const void* g, void* l) {
  __builtin_amdgcn_global_load_lds((const u32*)g, (LDS_AS u32*)l, 16, 0, 0);
}
#define MFMA16(a, b, c) __builtin_amdgcn_mfma_f32_16x16x32_bf16((a), (b), (c), 0, 0, 0)
#define MFMA32(a, b, c) __builtin_amdgcn_mfma_f32_32x32x16_bf16((a), (b), (c), 0, 0, 0)
DI s16x4 tr_read(const void* l) { return __builtin_amdgcn_ds_read_tr16_b64_v4i16((LDS_AS s16x4*)l); }

DI int rowmap(int mode, int n) {
  if (mode == 1) return n < 1472 ? n : (n < 1480 ? n - 1472 + 2624 : n - 8);
  if (mode == 2) return 64 * (n >> 5) + (n & 31);
  if (mode == 3) return 64 * (n >> 5) + (n & 31) + 32;
  return n;
}
__device__ __forceinline__ void transpose_tiles4(char* smem, const float* src, int ldn, int nvalid, int ntn, int t0, u16* dst, int ldk, int mode) {
  const int tid = fresh_tid();
  float4 v[4][4];
#pragma unroll
  for (int q = 0; q < 4; ++q) {
    const int t = t0 + q, k0 = (t / ntn) * 64, n0 = (t % ntn) * 64;
#pragma unroll
    for (int i = 0; i < 4; ++i) {
      const int k = (tid >> 4) + 16 * i, n = (tid & 15) * 4;
      v[q][i] = make_float4(0.f, 0.f, 0.f, 0.f);
      if (n0 + n + 3 < nvalid) v[q][i] = *(const float4*)(src + (size_t)(k0 + k) * ldn + n0 + n);
      else { float tt[4] = {0.f, 0.f, 0.f, 0.f};
        for (int e = 0; e < 4; ++e) if (n0 + n + e < nvalid) tt[e] = src[(size_t)(k0 + k) * ldn + n0 + n + e];
        v[q][i] = make_float4(tt[0], tt[1], tt[2], tt[3]); }
    }
  }
  __syncthreads();
#pragma unroll
  for (int q = 0; q < 4; ++q) {
    float* tile = (float*)smem + q * (64 * 65);
#pragma unroll
    for (int i = 0; i < 4; ++i) {
      const int k = (tid >> 4) + 16 * i, n = (tid & 15) * 4;
      tile[k * 65 + n] = v[q][i].x; tile[k * 65 + n + 1] = v[q][i].y; tile[k * 65 + n + 2] = v[q][i].z; tile[k * 65 + n + 3] = v[q][i].w;
    }
  }
  __syncthreads();
  const int nr = tid >> 2, ks = (tid & 3) * 16;
#pragma unroll
  for (int q = 0; q < 4; ++q) {
    const int t = t0 + q, k0 = (t / ntn) * 64, n0 = (t % ntn) * 64;
    const float* tile = (const float*)smem + q * (64 * 65);
    if (n0 + nr < nvalid) {
      float f[16];
#pragma unroll
      for (int j = 0; j < 16; ++j) f[j] = tile[(ks + j) * 65 + nr];
      const u32x4 lo4 = (u32x4){pack2(f[0], f[1]), pack2(f[2], f[3]), pack2(f[4], f[5]), pack2(f[6], f[7])};
      const u32x4 hi4 = (u32x4){pack2(f[8], f[9]), pack2(f[10], f[11]), pack2(f[12], f[13]), pack2(f[14], f[15])};
      u16* d = dst + (size_t)rowmap(mode, n0 + nr) * ldk + k0 + ks;
      *(u32x4*)d = lo4; *(u32x4*)(d + 8) = hi4;
      if (mode == 4) {
        float g[16];
#pragma unroll
        for (int j = 0; j < 16; ++j) g[j] = f[j] - bf2f(f2bf(f[j]));
        const u32x4 l0 = (u32x4){pack2(g[0], g[1]), pack2(g[2], g[3]), pack2(g[4], g[5]), pack2(g[6], g[7])};
        const u32x4 l1 = (u32x4){pack2(g[8], g[9]), pack2(g[10], g[11]), pack2(g[12], g[13]), pack2(g[14], g[15])};
        *(u32x4*)(d + 1024) = l0; *(u32x4*)(d + 1024 + 8) = l1;
        *(u32x4*)(d + 2048) = lo4; *(u32x4*)(d + 2048 + 8) = hi4;
      }
    }
  }
}

constexpr int PREP_T_IN = 16 * 42 / 4, PREP_T_OUT = 256 / 4, PREP_T_RT = 64 / 4, PREP_T_SG = 64 / 4, PREP_T_SU = 64 / 4, PREP_T_SD = 64 / 4;
constexpr int PREP_T_E = NEXP * 64 / 4;
constexpr int PREP_B0 = 0, PREP_B1 = PREP_B0 + PREP_T_IN, PREP_B2 = PREP_B1 + PREP_T_OUT, PREP_B3 = PREP_B2 + PREP_T_RT,
              PREP_B4 = PREP_B3 + PREP_T_SG, PREP_B5 = PREP_B4 + PREP_T_SU, PREP_B6 = PREP_B5 + PREP_T_SD,
              PREP_B7 = PREP_B6 + PREP_T_E, PREP_B8 = PREP_B7 + PREP_T_E, PREP_B9 = PREP_B8 + PREP_T_E;
constexpr int PREP_MOD = 96, PREP_ROPE = NTOK * 32 / 256, PREP_PAD = 1;
constexpr int PREP_ITEMS = PREP_B9 + PREP_MOD + PREP_ROPE + PREP_PAD;

__device__ __forceinline__ void phase_prep(const Params& p, char* smem, int bid, int nblk, bool experts) {
  char* ws = p.ws;
  const int tid = fresh_tid();
  for (int it = (experts ? PREP_B6 : 0) + bid; it < (experts ? PREP_B9 : PREP_ITEMS); it += nblk) {
    if (!experts && it >= PREP_B6 && it < PREP_B9) continue;
    if (it < PREP_B1) { transpose_tiles4(smem, p.w_in, 2632, 2632, 42, (it - PREP_B0) * 4, (u16*)(ws + O_WT_IN), 1024, 1); }
    else if (it < PREP_B2) { transpose_tiles4(smem, p.w_out, 1024, 1024, 16, (it - PREP_B1) * 4, (u16*)(ws + O_WT_OUT), 1024, 0); }
    else if (it < PREP_B3) { transpose_tiles4(smem, p.w_router, 256, 256, 4, (it - PREP_B2) * 4, (u16*)(ws + O_WT_RT), 3072, 4); }
    else if (it < PREP_B4) { transpose_tiles4(smem, p.ws_gate, 256, 256, 4, (it - PREP_B3) * 4, (u16*)(ws + O_WT_SGU), 1024, 2); }
    else if (it < PREP_B5) { transpose_tiles4(smem, p.ws_up, 256, 256, 4, (it - PREP_B4) * 4, (u16*)(ws + O_WT_SGU), 1024, 3); }
    else if (it < PREP_B6) { transpose_tiles4(smem, p.ws_down, 1024, 1024, 16, (it - PREP_B5) * 4, (u16*)(ws + O_WT_SD), 256, 0); }
    else if (it < PREP_B7) { const int t = it - PREP_B6, e = t >> 4;
      transpose_tiles4(smem, p.w_gate + (size_t)e * 1024 * 256, 256, 256, 4, (t & 15) * 4, (u16*)(ws + O_WT_EGU) + (size_t)e * 512 * 1024, 1024, 2); }
    else if (it < PREP_B8) { const int t = it - PREP_B7, e = t >> 4;
      transpose_tiles4(smem, p.w_up + (size_t)e * 1024 * 256, 256, 256, 4, (t & 15) * 4, (u16*)(ws + O_WT_EGU) + (size_t)e * 512 * 1024, 1024, 3); }
    else if (it < PREP_B9) { const int t = it - PREP_B8, e = t >> 4;
      transpose_tiles4(smem, p.w_down + (size_t)e * 256 * 1024, 1024, 1024, 16, (t & 15) * 4, (u16*)(ws + O_WT_ED) + (size_t)e * 1024 * 256, 256, 0); }
    else if (it < PREP_B9 + PREP_MOD) {
      const int n = (it - PREP_B9) * 64 + (tid & 63), kg = tid >> 6;
      float* sl = (float*)smem;
      __syncthreads();
      for (int i = tid; i < 4096; i += 256) sl[i] = silu_f(p.c[i]);
      __syncthreads();
      float a0 = 0.f, a1 = 0.f, a2 = 0.f, a3 = 0.f;
#pragma unroll 8
      for (int k = kg; k < 1024; k += 4) {
        float w = p.w_ada[(size_t)k * 6144 + n];
        a0 += sl[k] * w; a1 += sl[1024 + k] * w; a2 += sl[2048 + k] * w; a3 += sl[3072 + k] * w;
      }
      __syncthreads();
      float* ps = sl + 4096;
      ps[(kg * 4 + 0) * 64 + (tid & 63)] = a0; ps[(kg * 4 + 1) * 64 + (tid & 63)] = a1;
      ps[(kg * 4 + 2) * 64 + (tid & 63)] = a2; ps[(kg * 4 + 3) * 64 + (tid & 63)] = a3;
      __syncthreads();
      { const int b = tid >> 6, c = tid & 63;
        float s = p.b_ada[(it - PREP_B9) * 64 + c];
        for (int g = 0; g < 4; ++g) s += ps[(g * 4 + b) * 64 + c];
        ((float*)(ws + O_MOD))[b * 6144 + (it - PREP_B9) * 64 + c] = s; }
    }
    else if (it < PREP_B9 + PREP_MOD + PREP_ROPE) {
      const int idx = (it - PREP_B9 - PREP_MOD) * 256 + tid, tok = idx >> 5, i = idx & 31;
      const float inv = (float)exp(-(double)i * (9.210340371976184 / 32.0));
      const float ang = (float)p.pos[tok] * inv;
      double t = (double)ang * 0.15915494309189535; t -= rint(t);
      const float fr = (float)t;
      float2 cs = make_float2(__builtin_amdgcn_cosf(fr), __builtin_amdgcn_sinf(fr));
      ((float2*)(ws + O_ROPE))[idx] = cs;
    }
    else {
      u32* d = (u32*)((u16*)(ws + O_WT_IN) + (size_t)2632 * 1024);
      for (int i = tid; i < 56 * 512; i += 256) d[i] = 0u;
    }
  }
}

__device__ __forceinline__ void phase_norm(const Params& p, const float* src, const float* gain, int shc, int scc, bool write_lo, int bid, int nblk) {
  const int lane = fresh_tid() & 63, wid = fresh_tid() >> 6;
  const float* mod = (const float*)(p.ws + O_MOD);
  u16* H = (u16*)(p.ws + O_H);
  for (int it = bid; it < NTOK / 16; it += nblk) {
    for (int r = 0; r < 4; ++r) {
      const int tok = it * 16 + wid * 4 + r, b = tok >> 13;
      const float* xr = src + (size_t)tok * 1024;
      float4 v[4]; float ss = 0.f;
#pragma unroll
      for (int j = 0; j < 4; ++j) { v[j] = *(const float4*)(xr + lane * 4 + 256 * j); ss += v[j].x * v[j].x + v[j].y * v[j].y + v[j].z * v[j].z + v[j].w * v[j].w; }
      ss = wave_sum(ss);
      const float rstd = rsqrtf(ss * (1.f / 1024.f) + EPS_);
#pragma unroll
      for (int j = 0; j < 4; ++j) {
        const int col = lane * 4 + 256 * j;
        const float4 g = *(const float4*)(gain + col);
        const float4 sh = *(const float4*)(mod + b * 6144 + shc * 1024 + col);
        const float4 sc = *(const float4*)(mod + b * 6144 + scc * 1024 + col);
        float h0 = v[j].x * rstd * g.x * (1.f + sc.x) + sh.x, h1 = v[j].y * rstd * g.y * (1.f + sc.y) + sh.y;
        float h2 = v[j].z * rstd * g.z * (1.f + sc.z) + sh.z, h3 = v[j].w * rstd * g.w * (1.f + sc.w) + sh.w;
        u32x2 hi = {pack2(h0, h1), pack2(h2, h3)};
        *(u32x2*)(H + (size_t)tok * 2048 + col) = hi;
        if (write_lo) {
          float l0 = h0 - bf2f((u16)(hi[0] & 0xffff)), l1 = h1 - bf2f((u16)(hi[0] >> 16));
          float l2 = h2 - bf2f((u16)(hi[1] & 0xffff)), l3 = h3 - bf2f((u16)(hi[1] >> 16));
          u32x2 lo = {pack2(l0, l1), pack2(l2, l3)};
          *(u32x2*)(H + (size_t)tok * 2048 + 1024 + col) = lo;
        }
      }
    }
  }
}

struct GDesc { const u16* A; const u16* B; u32 aoffs[8]; u32 boff0, ldb; int split; };
template <class ARow>
DI GDesc g_make(const u16* A, ARow arow, const u16* B, int ldb, int split) {
  const int lane = fresh_tid() & 63, gsrc = (0x78 >> (2 * ((lane >> 4) & 3))) & 3;
  GDesc d; d.A = A; d.B = B; d.ldb = (u32)ldb; d.split = split;
#pragma unroll
  for (int i = 0; i < 8; ++i) d.aoffs[i] = (u32)arow(16 * i + (lane >> 2)) + ((lane & 3) ^ gsrc) * 8;
  d.boff0 = (u32)(lane >> 2) * (u32)ldb + ((lane & 3) ^ gsrc) * 8;
  return d;
}
DI void g_stage(char* smem, const GDesc& d, int t) {
  const int lane = fresh_tid() & 63;
  char* base = smem + (t & 3) * 16384 + lane * 16;
  const int ko = (d.split && t >= 32) ? t * 32 - 1024 : t * 32;
#pragma unroll
  for (int i = 0; i < 8; ++i) glds16(d.A + d.aoffs[i] + ko, base + i * 1024);
#pragma unroll
  for (int i = 0; i < 8; ++i) glds16(d.B + d.boff0 + (u32)(16 * i) * d.ldb + t * 32, base + 8192 + i * 1024);
}
DI void g_begin(char* smem, const GDesc& d, int nkt) {
  const int wid = __builtin_amdgcn_readfirstlane(fresh_tid() >> 6);
  __syncthreads();
  if (wid < 3 && wid < nkt) g_stage(smem, d, wid);
}
template <int ABL = 0>
DI void g_run(char* smem, const GDesc& d, int nkt, bool has_next, const GDesc& nx, f32x4 (&acc)[4][4]) {
  const int tid = fresh_tid(), lane = tid & 63, wid = __builtin_amdgcn_readfirstlane(tid >> 6), wr = wid >> 1, wc = wid & 1, fr = lane & 15, fq = lane >> 4;
  const int grd = (0x78 >> (2 * ((fr >> 2) & 3))) & 3, rdq = (fq ^ grd) * 16;
#pragma unroll
  for (int m = 0; m < 4; ++m)
#pragma unroll
    for (int n = 0; n < 4; ++n) acc[m][n] = (f32x4){0.f, 0.f, 0.f, 0.f};
  for (int t = 0; t < nkt; ++t) {
    if (wid == (t & 3)) asm volatile("s_waitcnt vmcnt(0)" ::: "memory");
    asm volatile("s_waitcnt lgkmcnt(0)" ::: "memory");
    __builtin_amdgcn_s_barrier();
    const int g = t + 3;
    if (!(ABL & 1) && wid == (g & 3)) { if (g < nkt) g_stage(smem, d, g); else if (has_next) g_stage(smem, nx, g - nkt); }
    const char* base = smem + (t & 3) * 16384;
    bf16x8 At[4], Bt[4];
#pragma unroll
    for (int m = 0; m < 4; ++m) At[m] = *(const bf16x8*)(base + (wr * 64 + m * 16 + fr) * 64 + rdq);
#pragma unroll
    for (int n = 0; n < 4; ++n) Bt[n] = *(const bf16x8*)(base + 8192 + (wc * 64 + n * 16 + fr) * 64 + rdq);
#pragma unroll
    for (int m = 0; m < 4; ++m)
#pragma unroll
      for (int n = 0; n < 4; ++n) acc[m][n] = MFMA16(Bt[n], At[m], acc[m][n]);
  }
}

struct G2Desc { const u16* A; const u16* B; u32 lda, ldb; int rmax; const u32* tab; };
DI void g2_stage_half(char* smem, const G2Desc& d, int t, int slot, int half) {
  const int lane = fresh_tid() & 63, gsrc = (0x78 >> (2 * ((lane >> 4) & 3))) & 3, pc = ((lane & 3) ^ gsrc) * 8;
  char* base = smem + slot * 24576 + lane * 16;
  if (half == 0) {
#pragma unroll
    for (int i = 0; i < 12; ++i) {
      const int r = 16 * i + (lane >> 2);
      const u32 ro = d.tab ? d.tab[r] : (u32)min(r, d.rmax) * d.lda;
      glds16(d.A + ro + pc + t * 32, base + i * 1024);
    }
  } else {
#pragma unroll
    for (int i = 12; i < 16; ++i) {
      const int r = 16 * i + (lane >> 2);
      const u32 ro = d.tab ? d.tab[r] : (u32)min(r, d.rmax) * d.lda;
      glds16(d.A + ro + pc + t * 32, base + i * 1024);
    }
#pragma unroll
    for (int i = 0; i < 8; ++i) glds16(d.B + (u32)(16 * i + (lane >> 2)) * d.ldb + pc + t * 32, base + 16384 + i * 1024);
  }
}
struct G2State { int g, slot; };
DI void g2_begin(char* smem, const G2Desc& d, int nkt, G2State& st) {
  const int wid = __builtin_amdgcn_readfirstlane(fresh_tid() >> 6);
  __syncthreads();
  st.g = 0; st.slot = 0;
  if ((wid >> 1) < nkt) g2_stage_half(smem, d, wid >> 1, wid >> 1, wid & 1);
}
DI void g2_run(char* smem, const G2Desc& d, int nkt, bool has_next, const G2Desc& nx, f32x4 (&acc)[8][4], G2State& st) {
  const int tid = fresh_tid(), lane = tid & 63, wid = __builtin_amdgcn_readfirstlane(tid >> 6), wr = wid >> 1, wc = wid & 1, fr = lane & 15, fq = lane >> 4;
  const int grd = (0x78 >> (2 * ((fr >> 2) & 3))) & 3, rdq = (fq ^ grd) * 16;
#pragma unroll
  for (int m = 0; m < 8; ++m)
#pragma unroll
    for (int n = 0; n < 4; ++n) acc[m][n] = (f32x4){0.f, 0.f, 0.f, 0.f};
  int g = st.g, slot = st.slot;
  for (int t = 0; t < nkt; ++t) {
    const bool mine = (wid >> 1) == (g & 1);
    if (mine) asm volatile("s_waitcnt vmcnt(0)" ::: "memory");
    asm volatile("s_waitcnt lgkmcnt(0)" ::: "memory");
    __builtin_amdgcn_s_barrier();
    if (mine) {
      const int s2 = slot >= 1 ? slot - 1 : 2;
      if (t + 2 < nkt) g2_stage_half(smem, d, t + 2, s2, wid & 1); else if (has_next) g2_stage_half(smem, nx, t + 2 - nkt, s2, wid & 1);
    }
    const char* base = smem + slot * 24576;
    bf16x8 Bt[4];
#pragma unroll
    for (int n = 0; n < 4; ++n) Bt[n] = *(const bf16x8*)(base + 16384 + (wc * 64 + n * 16 + fr) * 64 + rdq);
#pragma unroll
    for (int mh = 0; mh < 2; ++mh) {
      bf16x8 At[4];
#pragma unroll
      for (int m = 0; m < 4; ++m) At[m] = *(const bf16x8*)(base + (wr * 128 + (mh * 4 + m) * 16 + fr) * 64 + rdq);
#pragma unroll
      for (int m = 0; m < 4; ++m)
#pragma unroll
        for (int n = 0; n < 4; ++n) acc[mh * 4 + m][n] = MFMA16(Bt[n], At[m], acc[mh * 4 + m][n]);
    }
    ++g; slot = slot == 2 ? 0 : slot + 1;
  }
  st.g = g; st.slot = slot;
}

DI int xcd_item(int bid, int nblk, int k, int total) {
  const int x = bid & 7, v = bid >> 3, nv = nblk >> 3, per = (total + 7) >> 3;
  const int j = v + k * nv;
  if (j >= per) return -1;
  const int it = x * per + j;
  return it < total ? it : -1;
}
struct ARowLin { int ld; DI u32 operator()(int r) const { return (u32)r * (u32)ld; } };

template <int MR>
DI void epi_proj(const Params& p, f32x4 (&acc)[MR][4], int row0, int col0) {
  const int tid = fresh_tid(), lane = tid & 63, wid = tid >> 6, wr = wid >> 1, wc = wid & 1, fr = lane & 15, fq = lane >> 4;
  const int hh = (col0 + wc * 64) >> 6;
  char* ws = p.ws;
  const float2* rope = (const float2*)(ws + O_ROPE);
  if (hh == 41) {
    if (fq < 2) {
      float* WI = (float*)(ws + O_WI);
#pragma unroll
      for (int m = 0; m < MR; ++m) {
        const int tok = row0 + wr * (MR * 16) + m * 16 + fr;
        const float sc = 0.04419417382415922f;
        *(f32x4*)(WI + tok * 8 + 4 * fq) = (f32x4){acc[m][0][0] * sc, acc[m][0][1] * sc, acc[m][0][2] * sc, acc[m][0][3] * sc};
      }
    }
    return;
  }
  const int kind = (hh < 10 || (hh >= 23 && hh < 35)) ? 2 : (hh < 12 ? 2 : (hh < 14 ? 0 : (hh < 23 ? 1 : 0)));
  const bool kv = hh >= 10 && hh < 14;
  const float oscale = (hh < 10 || (hh >= 23 && hh < 29)) ? 0.125f : 1.f;
  size_t dbase; int dstride, dcol;
  if (hh < 10) { dbase = O_QA; dstride = 640; dcol = hh * 64; }
  else if (hh < 12) { dbase = O_KV; dstride = 128; dcol = 0; }
  else if (hh < 14) { dbase = O_KV; dstride = 128; dcol = 64; }
  else if (hh < 22) { dbase = O_QI; dstride = 512; dcol = (hh - 14) * 64; }
  else if (hh < 23) { dbase = O_KI; dstride = 64; dcol = 0; }
  else if (hh < 29) { dbase = O_QB; dstride = 384; dcol = (hh - 23) * 64; }
  else if (hh < 35) { dbase = O_KB; dstride = 384; dcol = (hh - 29) * 64; }
  else { dbase = O_VB; dstride = 384; dcol = (hh - 35) * 64; }
  u16* dst = (u16*)(ws + dbase);
  const int kvh = kv ? ((hh < 12) ? hh - 10 : hh - 12) : 0;
  f32x4 gn[4];
#pragma unroll
  for (int n = 0; n < 4; ++n) {
    const f32x4 ga = *(const f32x4*)(p.qna + n * 16 + 4 * fq), gb = *(const f32x4*)(p.kna + n * 16 + 4 * fq);
    const f32x4 gc = *(const f32x4*)(p.qnb + n * 16 + 4 * fq), gd = *(const f32x4*)(p.knb + n * 16 + 4 * fq);
    gn[n] = hh < 10 ? ga : hh < 12 ? gb : hh < 29 ? gc : gd;
  }
  float kss_max = 0.f;
#pragma unroll
  for (int m = 0; m < MR; ++m) {
    const int tok = row0 + wr * (MR * 16) + m * 16 + fr;
    f32x4 v[4];
#pragma unroll
    for (int n = 0; n < 4; ++n) v[n] = acc[m][n];
    if (kind == 2) {
      float ss = 0.f;
#pragma unroll
      for (int n = 0; n < 4; ++n)
#pragma unroll
        for (int j = 0; j < 4; ++j) ss = fmaf(v[n][j], v[n][j], ss);
      ss += __shfl_xor(ss, 16); ss += __shfl_xor(ss, 32);
      const float rstd = rsqrtf(ss * (1.f / 64.f) + EPS_);
#pragma unroll
      for (int n = 0; n < 4; ++n)
#pragma unroll
        for (int j = 0; j < 4; ++j) v[n][j] *= rstd * gn[n][j];
    }
    if (kind >= 1) {
#pragma unroll
      for (int n = 0; n < 2; ++n) {
        const f32x4 ca = *(const f32x4*)(rope + tok * 32 + n * 16 + 4 * fq);
        const f32x4 cb = *(const f32x4*)(rope + tok * 32 + n * 16 + 4 * fq + 2);
        const float cs[4] = {ca[0], ca[2], cb[0], cb[2]}, sn[4] = {ca[1], ca[3], cb[1], cb[3]};
#pragma unroll
        for (int j = 0; j < 4; ++j) {
          const float t1 = v[n][j], t2 = v[n + 2][j];
          v[n][j] = t1 * cs[j] - t2 * sn[j]; v[n + 2][j] = t2 * cs[j] + t1 * sn[j];
        }
      }
    }
    size_t rowoff;
    if (kv) { const int b = tok >> 13, s_ = tok & 8191; rowoff = ((size_t)(b * 2 + kvh) * 8192 + s_) * 128; }
    else rowoff = (size_t)tok * dstride;
    float kss = 0.f;
#pragma unroll
    for (int n = 0; n < 4; ++n) {
      const u32x2 pk = {pack2(v[n][0] * oscale, v[n][1] * oscale), pack2(v[n][2] * oscale, v[n][3] * oscale)};
      *(u32x2*)(dst + rowoff + dcol + n * 16 + 4 * fq) = pk;
      if (hh == 22) {
        const float a0 = __uint_as_float(pk[0] << 16), a1 = __uint_as_float(pk[0] & 0xffff0000u);
        const float a2 = __uint_as_float(pk[1] << 16), a3 = __uint_as_float(pk[1] & 0xffff0000u);
        kss += a0 * a0 + a1 * a1 + a2 * a2 + a3 * a3;
      }
    }
    if (hh == 22) { kss += __shfl_xor(kss, 16); kss += __shfl_xor(kss, 32); kss_max = fmaxf(kss_max, kss); }
  }
  if (hh == 22) {
#pragma unroll
    for (int o = 1; o < 16; o <<= 1) kss_max = fmaxf(kss_max, __shfl_xor(kss_max, o));
    if (lane == 0) atomicMax((u32*)(ws + O_KMAX) + (row0 >> 13), __float_as_uint(kss_max));
  }
}

__device__ __forceinline__ void phase_proj(const Params& p, char* smem, int bid, int nblk) {
  const u16* H = (const u16*)(p.ws + O_H);
  const u16* W = (const u16*)(p.ws + O_WT_IN);
  auto mk = [&](int it) { G2Desc d; d.A = H + (size_t)(it / 21) * 256 * 2048; d.B = W + (size_t)(it % 21) * 128 * 1024; d.lda = 2048; d.ldb = 1024; d.rmax = 255; d.tab = nullptr; return d; };
  int k = 0, it = xcd_item(bid, nblk, 0, 128 * 21);
  if (it < 0) return;
  G2Desc dc = mk(it); G2State st;
  g2_begin(smem, dc, 32, st);
  while (true) {
    const int itn = xcd_item(bid, nblk, ++k, 128 * 21);
    G2Desc dn = dc; if (itn >= 0) dn = mk(itn);
    f32x4 acc[8][4];
    g2_run(smem, dc, 32, itn >= 0, dn, acc, st);
    epi_proj<8>(p, acc, (it / 21) * 256, (it % 21) * 128);
    if (itn < 0) break;
    it = itn; dc = dn;
  }
}

__device__ __forceinline__ void phase_outproj(const Params& p, char* smem, int bid, int nblk) {
  const int tid = fresh_tid(), lane = tid & 63, wid = tid >> 6, wr = wid >> 1, wc = wid & 1, fr = lane & 15, fq = lane >> 4;
  const u16* A = (const u16*)(p.ws + O_O);
  const u16* W = (const u16*)(p.ws + O_WT_OUT);
  const float* mod = (const float*)(p.ws + O_MOD);
  auto mk = [&](int it) { G2Desc d; d.A = A + (size_t)(it >> 3) * 256 * 1024; d.B = W + (size_t)(it & 7) * 128 * 1024; d.lda = 1024; d.ldb = 1024; d.rmax = 255; d.tab = nullptr; return d; };
  int k = 0, it = xcd_item(bid, nblk, 0, 128 * 8);
  if (it < 0) return;
  G2Desc dc = mk(it); G2State st;
  g2_begin(smem, dc, 32, st);
  while (true) {
    const int itn = xcd_item(bid, nblk, ++k, 128 * 8);
    G2Desc dn = dc; if (itn >= 0) dn = mk(itn);
    f32x4 acc[8][4];
    g2_run(smem, dc, 32, itn >= 0, dn, acc, st);
    const int row0 = (it >> 3) * 256, col0 = (it & 7) * 128, b = row0 >> 13;
#pragma unroll
    for (int n = 0; n < 4; ++n) {
      const int col = col0 + wc * 64 + n * 16 + 4 * fq;
      const f32x4 gt = *(const f32x4*)(mod + b * 6144 + 2 * 1024 + col);
#pragma unroll
      for (int m = 0; m < 8; ++m) {
        const size_t o = (size_t)(row0 + wr * 128 + m * 16 + fr) * 1024 + col;
        const f32x4 xv = *(const f32x4*)(p.x + o);
        *(f32x4*)(p.out + o) = xv + gt * acc[m][n];
      }
    }
    if (itn < 0) break;
    it = itn; dc = dn;
  }
}

__device__ __forceinline__ void phase_router_sgu(const Params& p, char* smem, int bid, int nblk) {
  const int tid = fresh_tid(), lane = tid & 63, wid = tid >> 6, wr = wid >> 1, wc = wid & 1, fr = lane & 15, fq = lane >> 4;
  const u16* H = (const u16*)(p.ws + O_H);
  {
    const u16* W = (const u16*)(p.ws + O_WT_RT);
    float* L = (float*)(p.ws + O_LOGITS);
    int k = 0, it = xcd_item(bid, nblk, 0, 512);
    if (it >= 0) {
      GDesc dc = g_make(H + (size_t)(it >> 1) * 128 * 2048, ARowLin{2048}, W + (size_t)(it & 1) * 128 * 3072, 3072, 1);
      g_begin(smem, dc, 96);
      while (true) {
        const int itn = xcd_item(bid, nblk, ++k, 512);
        GDesc dn = dc;
        if (itn >= 0) dn = g_make(H + (size_t)(itn >> 1) * 128 * 2048, ARowLin{2048}, W + (size_t)(itn & 1) * 128 * 3072, 3072, 1);
        f32x4 acc[4][4];
        g_run(smem, dc, 96, itn >= 0, dn, acc);
        const int row0 = (it >> 1) * 128, col0 = (it & 1) * 128;
#pragma unroll
        for (int m = 0; m < 4; ++m)
#pragma unroll
          for (int n = 0; n < 4; ++n)
            *(f32x4*)(L + (size_t)(row0 + wr * 64 + m * 16 + fr) * 256 + col0 + wc * 64 + n * 16 + 4 * fq) = acc[m][n];
        if (itn < 0) break;
        it = itn; dc = dn;
      }
    }
  }
  {
    const u16* W = (const u16*)(p.ws + O_WT_SGU);
    u16* AS = (u16*)(p.ws + O_ACTS);
    int k = 0, it = xcd_item(bid, nblk, 0, 1024);
    if (it >= 0) {
      GDesc dc = g_make(H + (size_t)(it >> 2) * 128 * 2048, ARowLin{2048}, W + (size_t)(it & 3) * 128 * 1024, 1024, 0);
      g_begin(smem, dc, 32);
      while (true) {
        const int itn = xcd_item(bid, nblk, ++k, 1024);
        GDesc dn = dc;
        if (itn >= 0) dn = g_make(H + (size_t)(itn >> 2) * 128 * 2048, ARowLin{2048}, W + (size_t)(itn & 3) * 128 * 1024, 1024, 0);
        f32x4 acc[4][4];
        g_run(smem, dc, 32, itn >= 0, dn, acc);
        const int row0 = (it >> 2) * 128, col0 = (it & 3) * 128;
        const int acol0 = (col0 + wc * 64) >> 1;
#pragma unroll
        for (int m = 0; m < 4; ++m)
#pragma unroll
          for (int n = 0; n < 2; ++n) {
            const f32x4 g = acc[m][n], u = acc[m][n + 2];
            const u32x2 pk = {pack2(silu_f(g[0]) * u[0], silu_f(g[1]) * u[1]), pack2(silu_f(g[2]) * u[2], silu_f(g[3]) * u[3])};
            *(u32x2*)(AS + (size_t)(row0 + wr * 64 + m * 16 + fr) * 256 + acol0 + n * 16 + 4 * fq) = pk;
          }
        if (itn < 0) break;
        it = itn; dc = dn;
      }
    }
  }
}

DI void route_token(const Params& p, int tok) {
  const int lane = fresh_tid() & 63;
  const float4 lg = *(const float4*)((const float*)(p.ws + O_LOGITS) + (size_t)tok * 256 + lane * 4);
  const float4 bs = *(const float4*)(p.rbias + lane * 4);
  float sc[4] = {sigmoid_f(lg.x), sigmoid_f(lg.y), sigmoid_f(lg.z), sigmoid_f(lg.w)};
  float bi[4] = {sc[0] + bs.x, sc[1] + bs.y, sc[2] + bs.z, sc[3] + bs.w};
  float t1 = fmaxf(bi[0], bi[1]), t2 = fminf(bi[0], bi[1]);
  { float a = fmaxf(bi[2], bi[3]), b = fminf(bi[2], bi[3]);
    float n1 = fmaxf(t1, a), n2 = fmaxf(fminf(t1, a), fmaxf(t2, b)); t1 = n1; t2 = n2; }
#pragma unroll
  for (int o = 1; o < 8; o <<= 1) {
    float a = __shfl_xor(t1, o), b = __shfl_xor(t2, o);
    float n1 = fmaxf(t1, a), n2 = fmaxf(fminf(t1, a), fmaxf(t2, b)); t1 = n1; t2 = n2;
  }
  const float gs = t1 + t2;
  const int g = lane >> 3;
  int rank = 0;
#pragma unroll
  for (int gg = 0; gg < 8; ++gg) { const float o = __shfl(gs, gg * 8); rank += (o > gs || (o == gs && gg < g)) ? 1 : 0; }
  const bool allowed = rank < 4;
  float cand[4];
#pragma unroll
  for (int e = 0; e < 4; ++e) cand[e] = allowed ? bi[e] : -INFINITY;
  int sel[8]; float gsel[8]; float gsum = 0.f;
#pragma unroll
  for (int k = 0; k < 8; ++k) {
    float bv = cand[0]; int be = 0;
#pragma unroll
    for (int e = 1; e < 4; ++e) if (cand[e] > bv) { bv = cand[e]; be = e; }
    int bidx = lane * 4 + be;
#pragma unroll
    for (int o = 1; o < 64; o <<= 1) {
      const float ov = __shfl_xor(bv, o); const int oi = __shfl_xor(bidx, o);
      if (ov > bv || (ov == bv && oi < bidx)) { bv = ov; bidx = oi; }
    }
    sel[k] = bidx;
    const int ol = bidx >> 2, oe = bidx & 3;
    float sv = (oe == 0) ? sc[0] : (oe == 1) ? sc[1] : (oe == 2) ? sc[2] : sc[3];
    sv = __shfl(sv, ol);
    gsel[k] = sv; gsum += sv;
    if (lane == ol) {
#pragma unroll
      for (int e = 0; e < 4; ++e) if (e == oe) cand[e] = -INFINITY;
    }
  }
  if (lane < 8) {
    int e = sel[0]; float gv = gsel[0];
#pragma unroll
    for (int k = 1; k < 8; ++k) if (lane == k) { e = sel[k]; gv = gsel[k]; }
    const int pos = atomicAdd((int*)(p.ws + O_CNT) + e, 1);
    ((int*)(p.ws + O_SELE))[tok * 8 + lane] = e;
    ((float*)(p.ws + O_GATE))[tok * 8 + lane] = gv / gsum * 2.5f;
    ((int*)(p.ws + O_POSE))[tok * 8 + lane] = pos;
  }
}

__device__ __forceinline__ void phase_route_sdown(const Params& p, char* smem, int bid, int nblk) {
  const int tid = fresh_tid(), lane = tid & 63, wid = tid >> 6, wr = wid >> 1, wc = wid & 1, fr = lane & 15, fq = lane >> 4;
  for (int it = bid; it < NTOK / 64; it += nblk)
    for (int i = 0; i < 16; ++i) route_token(p, it * 64 + wid * 16 + i);
  const u16* A = (const u16*)(p.ws + O_ACTS);
  const u16* W = (const u16*)(p.ws + O_WT_SD);
  const float* mod = (const float*)(p.ws + O_MOD);
  int k = 0, it = xcd_item(bid, nblk, 0, 256 * 8);
  if (it < 0) return;
  GDesc dc = g_make(A + (size_t)(it >> 3) * 128 * 256, ARowLin{256}, W + (size_t)(it & 7) * 128 * 256, 256, 0);
  g_begin(smem, dc, 8);
  while (true) {
    const int itn = xcd_item(bid, nblk, ++k, 256 * 8);
    GDesc dn = dc;
    if (itn >= 0) dn = g_make(A + (size_t)(itn >> 3) * 128 * 256, ARowLin{256}, W + (size_t)(itn & 7) * 128 * 256, 256, 0);
    f32x4 acc[4][4];
    g_run(smem, dc, 8, itn >= 0, dn, acc);
    const int row0 = (it >> 3) * 128, col0 = (it & 7) * 128, b = row0 >> 13;
#pragma unroll
    for (int n = 0; n < 4; ++n) {
      const int col = col0 + wc * 64 + n * 16 + 4 * fq;
      const f32x4 gt = *(const f32x4*)(mod + b * 6144 + 5 * 1024 + col);
#pragma unroll
      for (int m = 0; m < 4; ++m) {
        const size_t o = (size_t)(row0 + wr * 64 + m * 16 + fr) * 1024 + col;
        const f32x4 ov = *(const f32x4*)(p.out + o);
        *(f32x4*)(p.out + o) = ov + gt * acc[m][n];
      }
    }
    if (itn < 0) break;
    it = itn; dc = dn;
  }
}

DI void expert_tables(const Params& p, int* off, int* toff, int tshift = 7) {
  const int tid = fresh_tid();
  __syncthreads();
  const int cnt = ((const int*)(p.ws + O_CNT))[tid];
  off[tid + 1] = cnt; toff[tid + 1] = (cnt + (1 << tshift) - 1) >> tshift;
  if (tid == 0) { off[0] = 0; toff[0] = 0; }
  __syncthreads();
  if (tid < 64) {
    int a[4], b[4]; int sa = 0, sb = 0;
#pragma unroll
    for (int i = 0; i < 4; ++i) { sa += off[1 + tid * 4 + i]; a[i] = sa; sb += toff[1 + tid * 4 + i]; b[i] = sb; }
    int pa = sa, pb = sb;
#pragma unroll
    for (int o = 1; o < 64; o <<= 1) { int ta = __shfl_up(pa, o), tb = __shfl_up(pb, o); if (tid >= o) { pa += ta; pb += tb; } }
    pa -= sa; pb -= sb;
#pragma unroll
    for (int i = 0; i < 4; ++i) { off[1 + tid * 4 + i] = pa + a[i]; toff[1 + tid * 4 + i] = pb + b[i]; }
  }
  __syncthreads();
}
DI int find_expert(const int* toff, int tile) {
  int lo = 0, hi = 255;
  while (lo < hi) { int mid = (lo + hi + 1) >> 1; if (toff[mid] <= tile) lo = mid; else hi = mid - 1; }
  return lo;
}

__device__ __forceinline__ void phase_dispatch(const Params& p, char* smem, int bid, int nblk) {
  int* off = (int*)(smem + 73728); int* toff = off + 260;
  expert_tables(p, off, toff);
  const int* sele = (const int*)(p.ws + O_SELE); const int* pose = (const int*)(p.ws + O_POSE);
  const float* gate = (const float*)(p.ws + O_GATE);
  int* tokslot = (int*)(p.ws + O_TOKSLOT); int* slottok = (int*)(p.ws + O_SLOTTOK); float* slotgate = (float*)(p.ws + O_SLOTGATE);
  for (int i = bid * THREADS + fresh_tid(); i < NSLOT; i += nblk * THREADS) {
    const int slot = off[sele[i]] + pose[i];
    tokslot[i] = slot; slottok[slot] = i >> 3; slotgate[slot] = gate[i];
  }
}

struct MoeItem { int e, s0, send, col0; };
DI MoeItem moe_item(const int* off, const int* toff, int it, int nshift) {
  const int tile = it >> nshift, nt = it & ((1 << nshift) - 1), e = find_expert(toff, tile);
  MoeItem m; m.e = e; m.s0 = off[e] + (tile - toff[e]) * 256; m.send = off[e + 1]; m.col0 = nt * 128;
  return m;
}
__device__ __forceinline__ void phase_moe_up(const Params& p, char* smem, int bid, int nblk) {
  const int tid = fresh_tid(), lane = tid & 63, wid = tid >> 6, wr = wid >> 1, wc = wid & 1, fr = lane & 15, fq = lane >> 4;
  int* off = (int*)(smem + 73728); int* toff = off + 260;
  u32* gtab = (u32*)(smem + 73728 + 2560);
  expert_tables(p, off, toff, 8);
  const int total = toff[256] * 4;
  const u16* H = (const u16*)(p.ws + O_H);
  const int* slottok = (const int*)(p.ws + O_SLOTTOK);
  u16* ACT = (u16*)(p.ws + O_ACT);
  auto mk = [&](const MoeItem& m, int par) {
    const int sl = m.s0 + tid;
    gtab[par * 256 + tid] = (u32)(sl < m.send ? slottok[sl] : 0) * 2048u;
    G2Desc d; d.A = H; d.B = (const u16*)(p.ws + O_WT_EGU) + (size_t)m.e * 512 * 1024 + (size_t)m.col0 * 1024; d.lda = 0; d.ldb = 1024; d.rmax = 255; d.tab = gtab + par * 256;
    return d;
  };
  int k = 0, it = xcd_item(bid, nblk, 0, total), par = 0;
  if (it < 0) return;
  MoeItem cur = moe_item(off, toff, it, 2);
  G2Desc dc = mk(cur, par); G2State st;
  g2_begin(smem, dc, 32, st);
  while (true) {
    const int itn = xcd_item(bid, nblk, ++k, total);
    MoeItem nxi = cur; G2Desc dn = dc;
    if (itn >= 0) { nxi = moe_item(off, toff, itn, 2); dn = mk(nxi, par ^ 1); }
    f32x4 acc[8][4];
    g2_run(smem, dc, 32, itn >= 0, dn, acc, st);
    const int acol0 = (cur.col0 + wc * 64) >> 1;
#pragma unroll
    for (int m = 0; m < 8; ++m) {
      const int slot = cur.s0 + wr * 128 + m * 16 + fr;
      if (slot < cur.send) {
#pragma unroll
        for (int n = 0; n < 2; ++n) {
          const f32x4 g = acc[m][n], u = acc[m][n + 2];
          const u32x2 pk = {pack2(silu_f(g[0]) * u[0], silu_f(g[1]) * u[1]), pack2(silu_f(g[2]) * u[2], silu_f(g[3]) * u[3])};
          *(u32x2*)(ACT + (size_t)slot * 256 + acol0 + n * 16 + 4 * fq) = pk;
        }
      }
    }
    if (itn < 0) break;
    cur = nxi; dc = dn; par ^= 1;
  }
}

__device__ __forceinline__ void phase_moe_down(const Params& p, char* smem, int bid, int nblk) {
  const int tid = fresh_tid(), lane = tid & 63, wid = tid >> 6, wr = wid >> 1, wc = wid & 1, fr = lane & 15, fq = lane >> 4;
  int* off = (int*)(smem + 73728); int* toff = off + 260;
  expert_tables(p, off, toff, 8);
  const int total = toff[256] * 8;
  const u16* ACT = (const u16*)(p.ws + O_ACT);
  const float* slotgate = (const float*)(p.ws + O_SLOTGATE);
  u16* Y = (u16*)(p.ws + O_BIG);
  auto mk = [&](const MoeItem& m) {
    G2Desc d; d.A = ACT + (size_t)m.s0 * 256; d.B = (const u16*)(p.ws + O_WT_ED) + (size_t)m.e * 1024 * 256 + (size_t)m.col0 * 256;
    d.lda = 256; d.ldb = 256; d.rmax = min(255, NSLOT - 1 - m.s0); d.tab = nullptr;
    return d;
  };
  int k = 0, it = xcd_item(bid, nblk, 0, total);
  if (it < 0) return;
  MoeItem cur = moe_item(off, toff, it, 3);
  G2Desc dc = mk(cur); G2State st;
  g2_begin(smem, dc, 8, st);
  while (true) {
    const int itn = xcd_item(bid, nblk, ++k, total);
    MoeItem nxi = cur; G2Desc dn = dc;
    if (itn >= 0) { nxi = moe_item(off, toff, itn, 3); dn = mk(nxi); }
    f32x4 acc[8][4];
    g2_run(smem, dc, 8, itn >= 0, dn, acc, st);
#pragma unroll
    for (int m = 0; m < 8; ++m) {
      const int slot = cur.s0 + wr * 128 + m * 16 + fr;
      if (slot < cur.send) {
        const float gw = slotgate[slot];
#pragma unroll
        for (int n = 0; n < 4; ++n) {
          const f32x4 a = acc[m][n];
          const u32x2 pk = {pack2(gw * a[0], gw * a[1]), pack2(gw * a[2], gw * a[3])};
          *(u32x2*)(Y + (size_t)slot * 1024 + cur.col0 + wc * 64 + n * 16 + 4 * fq) = pk;
        }
      }
    }
    if (itn < 0) break;
    cur = nxi; dc = dn;
  }
}

__device__ __forceinline__ void phase_combine(const Params& p, int bid, int nblk) {
  const int lane = fresh_tid() & 63, wid = fresh_tid() >> 6;
  const u16* Y = (const u16*)(p.ws + O_BIG);
  const int* tokslot = (const int*)(p.ws + O_TOKSLOT);
  const float* mod = (const float*)(p.ws + O_MOD);
  for (int it = bid; it < NTOK / 4; it += nblk) {
    const int tok = it * 4 + wid, b = tok >> 13;
    int sl[8];
#pragma unroll
    for (int k = 0; k < 8; ++k) sl[k] = tokslot[tok * 8 + k];
#pragma unroll
    for (int h = 0; h < 2; ++h) {
      const int col = h * 512 + lane * 8;
      float a[8] = {0.f, 0.f, 0.f, 0.f, 0.f, 0.f, 0.f, 0.f};
#pragma unroll
      for (int k = 0; k < 8; ++k) {
        const u32x4 v = *(const u32x4*)(Y + (size_t)sl[k] * 1024 + col);
#pragma unroll
        for (int e = 0; e < 4; ++e) { a[2 * e] += __uint_as_float(v[e] << 16); a[2 * e + 1] += __uint_as_float(v[e] & 0xffff0000u); }
      }
      float* o = p.out + (size_t)tok * 1024 + col;
      const float* g = mod + b * 6144 + 5 * 1024 + col;
      float4 o0 = *(float4*)o, o1 = *(float4*)(o + 4);
      const float4 g0 = *(const float4*)g, g1 = *(const float4*)(g + 4);
      o0.x += g0.x * a[0]; o0.y += g0.y * a[1]; o0.z += g0.z * a[2]; o0.w += g0.w * a[3];
      o1.x += g1.x * a[4]; o1.y += g1.y * a[5]; o1.z += g1.z * a[6]; o1.w += g1.w * a[7];
      *(float4*)o = o0; *(float4*)(o + 4) = o1;
    }
  }
}

constexpr int IDX_NB = 256, IDX_CB = 128;
constexpr int IX_A = 32768;
constexpr int IX_W = 65536, IX_SCALE = IX_W + 1024, IX_OFF = IX_SCALE + 128, IX_THR = IX_OFF + 128, IX_ABOVE = IX_THR + 128,
              IX_CIN = IX_ABOVE + 128, IX_LCS = IX_CIN + 128, IX_UCS = IX_LCS + 128, IX_FLAG = IX_UCS + 128, IX_DUMMY = IX_FLAG + 16,
              IX_LIST = IX_DUMMY + 16, IX_LIST_STRIDE = 256 + 1024, IX_END = IX_LIST + 4 * IX_LIST_STRIDE;
static_assert(IX_END <= SMEM_BYTES, "indexer LDS");
constexpr size_t O_BINS = O_O;
constexpr size_t BINS_PER_BATCH = (size_t)1024 * (256 * 257 / 2);
static_assert(O_BINS + 4 * BINS_PER_BATCH <= O_ACT, "bin image does not fit");

DI u32 mono_f32(float f) { const u32 u = __float_as_uint(f); return (u >> 31) ? ~u : (u | 0x80000000u); }

__device__ __forceinline__ void indexer_item(const Params& p, char* smem, int b, int qb) {
  const int tid = fresh_tid(), lane = tid & 63, wid = tid >> 6, hl = lane >> 5;
  const int q0 = qb * 32, tok0 = b * S_ + q0, KW = (qb + 1) * 32;
  const u16* QI = (const u16*)(p.ws + O_QI);
  const u16* KI = (const u16*)(p.ws + O_KI) + (size_t)b * S_ * 64;
  const float* WI = (const float*)(p.ws + O_WI);
  u16* SEL = (u16*)(p.ws + O_SEL);
  int* SELCNT = (int*)(p.ws + O_SELCNT);
  unsigned char* BINS = (unsigned char*)(p.ws + O_BINS) + (size_t)b * BINS_PER_BATCH + (size_t)1024 * (qb * (qb + 1) / 2);
  float* w_lds = (float*)(smem + IX_W);
  float* sc_lds = (float*)(smem + IX_SCALE); float* of_lds = (float*)(smem + IX_OFF);
  float* lcs_lds = (float*)(smem + IX_LCS); float* ucs_lds = (float*)(smem + IX_UCS);
  int* thr_lds = (int*)(smem + IX_THR); int* above_lds = (int*)(smem + IX_ABOVE); int* cin_lds = (int*)(smem + IX_CIN);
  int* flag_lds = (int*)(smem + IX_FLAG);
  u32* hist = (u32*)smem;
  __syncthreads();
  {
    const int q = tid >> 3, h = tid & 7;
    const u16* qr = QI + (size_t)(tok0 + q) * 512 + h * 64;
    float ss = 0.f;
#pragma unroll
    for (int i = 0; i < 8; ++i) { const u32x4 v = *(const u32x4*)(qr + i * 8);
      *(u32x4*)(smem + IX_A + tid * 128 + ((i ^ ((tid >> 1) & 7)) * 16)) = v;
#pragma unroll
      for (int e = 0; e < 4; ++e) { float a = __uint_as_float(v[e] << 16), c = __uint_as_float(v[e] & 0xffff0000u); ss += a * a + c * c; } }
    const float kmax = sqrtf(__uint_as_float(((const u32*)(p.ws + O_KMAX))[b]));
    const float nrm = sqrtf(ss) * kmax, w = WI[(tok0 + q) * 8 + h];
    w_lds[q * 8 + h] = 0.5f * w;
    float ps = w > 0.f ? w * nrm : 0.f, ns = w < 0.f ? -w * nrm : 0.f;
    float mu = w * nrm * (0.3989423f * 0.125f), var = w * w * nrm * nrm * (0.3408f / 64.f);
#pragma unroll
    for (int o = 1; o < 8; o <<= 1) { ps += __shfl_xor(ps, o); ns += __shfl_xor(ns, o); mu += __shfl_xor(mu, o); var += __shfl_xor(var, o); }
    float U = ps, L = -ns; const float span = U - L;
    U += span * 1e-3f + 1e-30f; L -= span * 1e-3f + 1e-30f;
    const float sd = sqrtf(var);
    const float pq = fminf(256.f / (float)(q0 + q + 1), 0.999f), pt = pq > 0.5f ? 1.f - pq : pq;
    const float tt_ = sqrtf(-2.f * __logf(pt));
    float zq = tt_ - (2.515517f + 0.802853f * tt_ + 0.010328f * tt_ * tt_) / (1.f + 1.432788f * tt_ + 0.189269f * tt_ * tt_ + 0.001308f * tt_ * tt_ * tt_);
    zq = pq > 0.5f ? -zq : zq;
    const float lo = fmaxf(L, mu + (zq - 3.5f) * sd), hi = fminf(U, mu + (zq + 3.5f) * sd);
    const float scale = (float)(IDX_NB - 2) / fmaxf(hi - lo, 1e-30f);
    if (h == 0) { sc_lds[q] = scale; of_lds[q] = 1.f - lo * scale; lcs_lds[q] = L; ucs_lds[q] = U;
                  thr_lds[q] = -1; above_lds[q] = 0; cin_lds[q] = 0; }
    if (tid == 0) flag_lds[0] = 0;
  }
  for (int i = tid; i < 32768 / 16; i += THREADS) ((u32x4*)smem)[i] = (u32x4){0u, 0u, 0u, 0u};
  int aoff[4];
  { const int r = lane & 31, tq = 2 * ((r >> 2) & 1) + (r >> 4), h = (r & 3) + 4 * ((r >> 3) & 1), rowg = tq * 8 + h;
#pragma unroll
    for (int ks = 0; ks < 4; ++ks) aoff[ks] = IX_A + rowg * 128 + (((2 * ks + hl) ^ ((rowg >> 1) & 7)) * 16); }
  __syncthreads();
  const int nchunk = (qb + 4) >> 2;
  int iter = 0;
  bool again = (q0 + 32) > NSEL;
  while (again) {
    for (int ch = wid; ch < nchunk; ch += 4) {
      bf16x8 Bf[4][4];
#pragma unroll
      for (int tt = 0; tt < 4; ++tt) {
        const int keyl = min((ch * 4 + tt) * 32 + (lane & 31), S_ - 1);
#pragma unroll
        for (int ks = 0; ks < 4; ++ks) Bf[tt][ks] = *(const bf16x8*)(KI + (size_t)keyl * 64 + ks * 16 + 8 * hl);
      }
#pragma unroll 1
      for (int rt = 0; rt < 8; ++rt) {
        bf16x8 Af[4];
#pragma unroll
        for (int ks = 0; ks < 4; ++ks) Af[ks] = *(const bf16x8*)(smem + aoff[ks] + rt * 4096);
        const int qa = rt * 4 + 2 * hl;
        const f32x4 wa0 = *(const f32x4*)(w_lds + qa * 8), wa1 = *(const f32x4*)(w_lds + qa * 8 + 4);
        const f32x4 wb0 = *(const f32x4*)(w_lds + qa * 8 + 8), wb1 = *(const f32x4*)(w_lds + qa * 8 + 12);
        const float sca = sc_lds[qa], scb = sc_lds[qa + 1], ofa = of_lds[qa], ofb = of_lds[qa + 1];
#pragma unroll
        for (int tp = 0; tp < 2; ++tp) {
          f32x16 acc[2];
#pragma unroll
          for (int t2 = 0; t2 < 2; ++t2) {
#pragma unroll
            for (int i = 0; i < 16; ++i) acc[t2][i] = 0.f;
#pragma unroll
            for (int ks = 0; ks < 4; ++ks) acc[t2] = MFMA32(Af[ks], Bf[tp * 2 + t2][ks], acc[t2]);
          }
#pragma unroll
          for (int t2 = 0; t2 < 2; ++t2) {
            const int kt = ch * 4 + tp * 2 + t2;
            if (kt <= qb) {
              const int key = kt * 32 + (lane & 31);
#pragma unroll
              for (int u = 0; u < 2; ++u) {
                const int q = qa + u;
                const f32x4 w0 = u ? wb0 : wa0, w1 = u ? wb1 : wa1;
                float s1 = 0.f, s2 = 0.f;
#pragma unroll
                for (int h = 0; h < 4; ++h) { const float x = acc[t2][8 * u + h]; s1 = fmaf(w0[h], x, s1); s2 = fmaf(w0[h], __builtin_fabsf(x), s2); }
#pragma unroll
                for (int h = 0; h < 4; ++h) { const float x = acc[t2][8 * u + 4 + h]; s1 = fmaf(w1[h], x, s1); s2 = fmaf(w1[h], __builtin_fabsf(x), s2); }
                const float s = s1 + s2;
                int bin = (int)fmaf(s, u ? scb : sca, u ? ofb : ofa);
                bin = min(max(bin, 0), IDX_NB - 1);
                const bool valid = key <= q0 + q;
                atomicAdd((u32*)(smem + (valid ? (q * IDX_NB + bin) * 4 : IX_DUMMY)), 1u);
                BINS[(u32)(q * KW + key)] = (unsigned char)bin;
              }
            }
          }
        }
      }
    }
    __syncthreads();
    for (int qq = 0; qq < 8; ++qq) {
      const int q = wid * 8 + qq;
      const u32x4 wv = *(const u32x4*)(hist + q * IDX_NB + lane * 4);
      const int local = (int)(wv[0] + wv[1] + wv[2] + wv[3]);
      int suf = local;
#pragma unroll
      for (int o = 1; o < 64; o <<= 1) { const int t = __shfl_down(suf, o); if (lane + o < 64) suf += t; }
      if (suf >= NSEL && suf - local < NSEL) {
        int cum = suf - local, bt = 0, ab = 0, cin = 0; bool found = false;
#pragma unroll
        for (int i = 3; i >= 0; --i) {
          const int c = (int)wv[i];
          if (!found) { if (cum + c >= NSEL) { found = true; bt = lane * 4 + i; ab = cum; cin = c; } else cum += c; }
        }
        thr_lds[q] = bt; above_lds[q] = ab; cin_lds[q] = cin;
        if (cin > IDX_CB) flag_lds[0] = 1;
      }
    }
    __syncthreads();
    again = flag_lds[0] != 0 && iter < 3;
    __syncthreads();
    if (again) {
      if (tid < 32 && cin_lds[tid] > IDX_CB) {
        const int q = tid, bt = thr_lds[q];
        const float sc = sc_lds[q], of = of_lds[q], inv = 1.f / sc;
        float lo = ((float)bt - of) * inv, hi = ((float)(bt + 1) - of) * inv;
        if (bt == 0) lo = lcs_lds[q];
        if (bt == IDX_NB - 1) hi = ucs_lds[q];
        const float wdt = hi - lo; lo -= 0.02f * wdt; hi += 0.02f * wdt;
        const float nsc = (float)(IDX_NB - 2) / (hi - lo);
        if (nsc < 1e30f && nsc > sc) { sc_lds[q] = nsc; of_lds[q] = 1.f - lo * nsc; }
      }
      if (tid == 0) flag_lds[0] = 0;
      ++iter;
      for (int i = tid; i < 32768 / 16; i += THREADS) ((u32x4*)smem)[i] = (u32x4){0u, 0u, 0u, 0u};
      __syncthreads();
    }
  }
  asm volatile("s_waitcnt vmcnt(0)" ::: "memory");
  __syncthreads();
  u16* ambk = (u16*)(smem + IX_LIST + wid * IX_LIST_STRIDE);
  u64* comp = (u64*)(smem + IX_LIST + wid * IX_LIST_STRIDE + 256);
  const unsigned long long lt_mask = (1ull << lane) - 1ull;
  for (int qq = 0; qq < 8; ++qq) {
    const int q = wid * 8 + qq, tok = tok0 + q, n = q0 + q + 1;
    u16* selrow = SEL + (size_t)tok * NSEL;
    int total;
    if (n <= NSEL) {
      for (int i = lane; i < n; i += 64) selrow[i] = (u16)i;
      total = n;
    } else {
      const int tc = thr_lds[q];
      const unsigned char* row = BINS + (size_t)q * KW;
      int base = 0, na = 0;
      u32 w4[4];
#pragma unroll
      for (int u = 0; u < 4; ++u) w4[u] = __builtin_nontemporal_load((const u32*)(row + (u32)(lane * 4)) + u * 64);
#pragma unroll 1
      for (int k0 = 0; k0 < n; k0 += 1024) {
        u32 wn[4] = {0u, 0u, 0u, 0u};
        if (k0 + 1024 < n) {
#pragma unroll
          for (int u = 0; u < 4; ++u) wn[u] = __builtin_nontemporal_load((const u32*)(row + (u32)(k0 + 1024 + lane * 4)) + u * 64);
        }
#pragma unroll
        for (int u = 0; u < 4; ++u) {
          const int kk = k0 + u * 256 + lane * 4;
#pragma unroll
          for (int j = 0; j < 4; ++j) {
            const int key = kk + j, cb = (int)((w4[u] >> (8 * j)) & 255u);
            const bool valid = key < n, ab = valid && cb > tc, am = valid && cb == tc;
            const unsigned long long mA = __ballot(ab), mB = __ballot(am);
            if (ab) { const int pos = base + __popcll(mA & lt_mask); if (pos < NSEL) selrow[pos] = (u16)key; }
            if (am) { const int pos = na + __popcll(mB & lt_mask); if (pos < IDX_CB) ambk[pos] = (u16)key; }
            base += __popcll(mA); na += __popcll(mB);
          }
        }
#pragma unroll
        for (int u = 0; u < 4; ++u) w4[u] = wn[u];
      }
      base = min(base, NSEL); na = min(na, IDX_CB);
      const int r = NSEL - base;
#pragma unroll 1
      for (int half = 0; half < 2; ++half) {
        const int e = lane + 64 * half;
        if (e < na) {
          const int key = ambk[e];
          const u16* kr = KI + (size_t)key * 64;
          float d[8] = {0.f, 0.f, 0.f, 0.f, 0.f, 0.f, 0.f, 0.f};
          u32x4 kvr[8];
#pragma unroll
          for (int pc = 0; pc < 8; ++pc) kvr[pc] = *(const u32x4*)(kr + pc * 8);
#pragma unroll
          for (int pc = 0; pc < 8; ++pc) {
            const u32x4 kv = kvr[pc];
#pragma unroll
            for (int h = 0; h < 8; ++h) {
              const int rowg = q * 8 + h;
              const u32x4 qv = *(const u32x4*)(smem + IX_A + rowg * 128 + ((pc ^ ((rowg >> 1) & 7)) * 16));
#pragma unroll
              for (int c = 0; c < 4; ++c) {
                d[h] = fmaf(__uint_as_float(qv[c] << 16), __uint_as_float(kv[c] << 16), d[h]);
                d[h] = fmaf(__uint_as_float(qv[c] & 0xffff0000u), __uint_as_float(kv[c] & 0xffff0000u), d[h]);
              }
            }
          }
          float sc = 0.f;
#pragma unroll
          for (int h = 0; h < 8; ++h) sc = fmaf(w_lds[q * 8 + h], d[h] + __builtin_fabsf(d[h]), sc);
          comp[e] = ((u64)mono_f32(sc) << 16) | (u64)(0xFFFF - key);
        }
      }
#pragma unroll 1
      for (int half = 0; half < 2; ++half) {
        const int e = lane + 64 * half;
        const u64 my = e < na ? comp[e] : 0ull;
        int rank = 0;
#pragma unroll 8
        for (int j = 0; j < na; ++j) rank += (comp[j] > my) ? 1 : 0;
        if (e < na && rank < r) selrow[base + rank] = (u16)(0xFFFF - (int)(my & 0xFFFF));
      }
      total = base + min(r, na);
    }
    if (lane == 0) SELCNT[tok] = total;
  }
}

__device__ __forceinline__ void phase_indexer(const Params& p, char* smem, int bid, int nblk) {
  for (int it = bid; it < 1024; it += nblk) {
    const int b = it & 3, j = (it & 511) >> 2, qb = it < 512 ? j : 255 - j;
    indexer_item(p, smem, b, qb);
  }
}

__device__ __forceinline__ void dilated_item(const Params& p, char* smem, int item) {
  const int tid = fresh_tid(), lane = tid & 63, wid = tid >> 6, hl = lane >> 5, ql = lane & 31, i16 = lane & 15;
  const int br = item / 1536, rem = item % 1536, b = rem / 384, h = (rem % 384) >> 6, blk = rem & 63;
  const int lg = 2 * br, dil = 1 << lg, nper = 64 >> lg, r = blk / nper, n = blk % nper;
  const u16* QB = (const u16*)(p.ws + O_QB) + (size_t)b * S_ * 384 + h * 64;
  const u16* KB = (const u16*)(p.ws + O_KB) + (size_t)b * S_ * 384 + h * 64;
  const u16* VB = (const u16*)(p.ws + O_VB) + (size_t)b * S_ * 384 + h * 64;
  __syncthreads();
#pragma unroll
  for (int jj = 0; jj < 8; ++jj) {
    const int piece = tid + 256 * jj, row = piece >> 3, c = piece & 7, mk = 128 * (n - 1) + row;
    u32x4 v = (u32x4){0u, 0u, 0u, 0u};
    if (mk >= 0) v = *(const u32x4*)(VB + (size_t)(mk * dil + r) * 384 + c * 8);
    *(u32x4*)(smem + row * 128 + ((c ^ (((row >> 1) & 1) << 2)) * 16)) = v;
  }
  __syncthreads();
  const int mq0 = 128 * n + 32 * wid;
  bf16x8 Qf[4];
#pragma unroll
  for (int ks = 0; ks < 4; ++ks) Qf[ks] = *(const bf16x8*)(QB + (size_t)((mq0 + ql) * dil + r) * 384 + ks * 16 + 8 * hl);
  f32x16 S[5];
#pragma unroll
  for (int i = 0; i < 5; ++i) {
    const int mk = max(mq0 - 128 + 32 * i + ql, 0);
    const u16* kr = KB + (size_t)(mk * dil + r) * 384 + 8 * hl;
#pragma unroll
    for (int e = 0; e < 16; ++e) S[i][e] = 0.f;
#pragma unroll
    for (int ks = 0; ks < 4; ++ks) S[i] = MFMA32(*(const bf16x8*)(kr + ks * 16), Qf[ks], S[i]);
  }
  float mx = -1e30f;
#pragma unroll
  for (int i = 0; i < 5; ++i)
#pragma unroll
    for (int e = 0; e < 16; ++e) {
      const int cr = (e & 3) + 8 * (e >> 2) + 4 * hl;
      const int key = mq0 - 128 + 32 * i + cr, mq = mq0 + ql;
      const bool valid = key >= 0 && key <= mq && key >= mq - 128;
      S[i][e] = valid ? S[i][e] : -1e30f;
      mx = fmaxf(mx, S[i][e]);
    }
  mx = fmaxf(mx, __shfl_xor(mx, 32));
  float ls = 0.f;
#pragma unroll
  for (int i = 0; i < 5; ++i)
#pragma unroll
    for (int e = 0; e < 16; ++e) { const float pv = __expf(S[i][e] - mx); S[i][e] = pv; ls += pv; }
  ls += __shfl_xor(ls, 32);
  f32x16 O[2];
#pragma unroll
  for (int dt = 0; dt < 2; ++dt)
#pragma unroll
    for (int e = 0; e < 16; ++e) O[dt][e] = 0.f;
#pragma unroll
  for (int i = 0; i < 5; ++i)
#pragma unroll
    for (int s = 0; s < 2; ++s) {
      const bf16x8 Pf = pack8(S[i][8 * s], S[i][8 * s + 1], S[i][8 * s + 2], S[i][8 * s + 3], S[i][8 * s + 4], S[i][8 * s + 5], S[i][8 * s + 6], S[i][8 * s + 7]);
#pragma unroll
      for (int dt = 0; dt < 2; ++dt) {
        const int row1 = 32 * wid + 32 * i + 16 * s + 4 * hl + (i16 >> 2), row2 = row1 + 8;
        const int c = 4 * dt + 2 * ((lane >> 4) & 1) + ((i16 & 3) >> 1), by = 8 * (i16 & 1);
        const s16x4 lo = tr_read(smem + row1 * 128 + ((c ^ (((row1 >> 1) & 1) << 2)) * 16) + by);
        const s16x4 hi = tr_read(smem + row2 * 128 + ((c ^ (((row2 >> 1) & 1) << 2)) * 16) + by);
        const bf16x8 Vf = __builtin_shufflevector(lo, hi, 0, 1, 2, 3, 4, 5, 6, 7);
        O[dt] = MFMA32(Pf, Vf, O[dt]);
      }
    }
  u16* DN = (u16*)(p.ws + O_DNUM) + ((size_t)br * NTOK + (size_t)b * S_) * 384 + h * 64;
  float* DM = (float*)(p.ws + O_DML) + ((size_t)br * NTOK + (size_t)b * S_) * 12 + h * 2;
#pragma unroll
  for (int dt = 0; dt < 2; ++dt)
#pragma unroll
    for (int e = 0; e < 16; ++e) {
      const int cr = (e & 3) + 8 * (e >> 2) + 4 * hl, s = (mq0 + cr) * dil + r;
      DN[(size_t)s * 384 + dt * 32 + ql] = f2bf(O[dt][e]);
    }
  if (hl == 0) { const int s = (mq0 + ql) * dil + r; DM[(size_t)s * 12] = mx; DM[(size_t)s * 12 + 1] = ls; }
}
__device__ __forceinline__ void phase_dilated(const Params& p, char* smem, int bid, int nblk) {
  for (int it = bid; it < 4608; it += nblk) dilated_item(p, smem, it);
}
__device__ __forceinline__ void phase_dil_combine(const Params& p, int bid, int nblk) {
  const u16* DN = (const u16*)(p.ws + O_DNUM); const float* DM = (const float*)(p.ws + O_DML);
  u16* O = (u16*)(p.ws + O_O);
  for (int i = bid * THREADS + fresh_tid(); i < NTOK * 6 * 8; i += nblk * THREADS) {
    const int tok = i / 48, rem = i % 48, h = rem >> 3, d0 = (rem & 7) * 8;
    float m[3], l[3];
#pragma unroll
    for (int br = 0; br < 3; ++br) { m[br] = DM[((size_t)br * NTOK + tok) * 12 + h * 2]; l[br] = DM[((size_t)br * NTOK + tok) * 12 + h * 2 + 1]; }
    const float mm = fmaxf(m[0], fmaxf(m[1], m[2]));
    float w[3], den = 0.f;
#pragma unroll
    for (int br = 0; br < 3; ++br) { w[br] = __expf(m[br] - mm); den += w[br] * l[br]; }
    const float inv = 1.f / den;
    float a[8] = {0.f, 0.f, 0.f, 0.f, 0.f, 0.f, 0.f, 0.f};
#pragma unroll
    for (int br = 0; br < 3; ++br) {
      const u32x4 v = *(const u32x4*)(DN + ((size_t)br * NTOK + tok) * 384 + h * 64 + d0);
#pragma unroll
      for (int e = 0; e < 4; ++e) { a[2 * e] += w[br] * __uint_as_float(v[e] << 16); a[2 * e + 1] += w[br] * __uint_as_float(v[e] & 0xffff0000u); }
    }
    u32x4 o = {pack2(a[0] * inv, a[1] * inv), pack2(a[2] * inv, a[3] * inv), pack2(a[4] * inv, a[5] * inv), pack2(a[6] * inv, a[7] * inv)};
    *(u32x4*)(O + (size_t)tok * 1024 + 640 + h * 64 + d0) = o;
  }
}

__device__ __forceinline__ void sparse_item(const Params& p, char* wbase, int b, int kvh, int q, int (&kraw)[16], int& cnt_io, bool has_next, int qn) {
  const int lane = fresh_tid() & 63, g = lane & 15, G = lane >> 4, i16 = g;
  const int tok = b * S_ + q;
  const u16* QA = (const u16*)(p.ws + O_QA) + (size_t)tok * 640 + kvh * 320;
  const u16* KV = (const u16*)(p.ws + O_KV) + (size_t)(b * 2 + kvh) * S_ * 128;
  const int cnt = cnt_io;
  bf16x8 Qf[2];
#pragma unroll
  for (int ks = 0; ks < 2; ++ks) {
    Qf[ks] = (bf16x8){0, 0, 0, 0, 0, 0, 0, 0};
    if (g < 5) Qf[ks] = *(const bf16x8*)(QA + g * 64 + ks * 32 + 8 * G);
  }
  int keys[16];
#pragma unroll
  for (int i = 0; i < 16; ++i) keys[i] = (16 * i + g) < cnt ? kraw[i] : 0;
  u32x4 vpre[8];
  auto vload = [&](int ci) {
#pragma unroll
    for (int ii = 0; ii < 8; ++ii) {
      const int key = __shfl(keys[4 * ci + (ii >> 1)], 8 * (ii & 1) + (lane >> 3));
      vpre[ii] = *(const u32x4*)(KV + (size_t)key * 128 + 64 + (lane & 7) * 8);
    }
  };
  vload(0);
  f32x4 S[16];
#pragma unroll
  for (int bb = 0; bb < 2; ++bb) {
    bf16x8 ka[8], kb[8];
#pragma unroll
    for (int i = 0; i < 8; ++i) {
      const u16* kr = KV + (size_t)keys[8 * bb + i] * 128 + 8 * G;
      ka[i] = *(const bf16x8*)kr; kb[i] = *(const bf16x8*)(kr + 32);
    }
#pragma unroll
    for (int i = 0; i < 8; ++i) {
      S[8 * bb + i] = (f32x4){0.f, 0.f, 0.f, 0.f};
      S[8 * bb + i] = MFMA16(ka[i], Qf[0], S[8 * bb + i]);
      S[8 * bb + i] = MFMA16(kb[i], Qf[1], S[8 * bb + i]);
    }
    __builtin_amdgcn_sched_barrier(0);
  }
  if (has_next) {
    const u16* seln = (const u16*)(p.ws + O_SEL) + (size_t)(b * S_ + qn) * NSEL;
#pragma unroll
    for (int i = 0; i < 16; ++i) kraw[i] = (int)seln[16 * i + g];
    cnt_io = ((const int*)(p.ws + O_SELCNT))[b * S_ + qn];
  }
  float mx = -1e30f;
#pragma unroll
  for (int i = 0; i < 16; ++i)
#pragma unroll
    for (int e = 0; e < 4; ++e) { const bool valid = (16 * i + 4 * G + e) < cnt; S[i][e] = valid ? S[i][e] : -1e30f; mx = fmaxf(mx, S[i][e]); }
  mx = fmaxf(mx, __shfl_xor(mx, 16)); mx = fmaxf(mx, __shfl_xor(mx, 32));
  float ls = 0.f;
#pragma unroll
  for (int i = 0; i < 16; ++i)
#pragma unroll
    for (int e = 0; e < 4; ++e) { const float pv = __expf(S[i][e] - mx); S[i][e] = pv; ls += pv; }
  ls += __shfl_xor(ls, 16); ls += __shfl_xor(ls, 32);
  f32x4 O[4];
#pragma unroll
  for (int nt = 0; nt < 4; ++nt) O[nt] = (f32x4){0.f, 0.f, 0.f, 0.f};
#pragma unroll
  for (int ci = 0; ci < 4; ++ci) {
#pragma unroll
    for (int ii = 0; ii < 8; ++ii) {
      const int row = 8 * ii + (lane >> 3), c = lane & 7;
      *(u32x4*)(wbase + row * 128 + ((c ^ (((row >> 1) & 3) << 1)) * 16)) = vpre[ii];
    }
    if (ci < 3) vload(ci + 1);
#pragma unroll
    for (int i2 = 0; i2 < 2; ++i2) {
      const int t0 = 4 * ci + 2 * i2;
      const bf16x8 Pf = pack8(S[t0][0], S[t0][1], S[t0][2], S[t0][3], S[t0 + 1][0], S[t0 + 1][1], S[t0 + 1][2], S[t0 + 1][3]);
#pragma unroll
      for (int nt = 0; nt < 4; ++nt) {
        const int row1 = 32 * i2 + 4 * G + (i16 >> 2), row2 = row1 + 16;
        const int c = 2 * nt + ((i16 & 3) >> 1), by = 8 * (i16 & 1);
        const s16x4 lo = tr_read(wbase + row1 * 128 + ((c ^ (((row1 >> 1) & 3) << 1)) * 16) + by);
        const s16x4 hi = tr_read(wbase + row2 * 128 + ((c ^ (((row2 >> 1) & 3) << 1)) * 16) + by);
        const bf16x8 Vf = __builtin_shufflevector(lo, hi, 0, 1, 2, 3, 4, 5, 6, 7);
        O[nt] = MFMA16(Pf, Vf, O[nt]);
      }
    }
  }
  u16* Oo = (u16*)(p.ws + O_O) + (size_t)tok * 1024 + kvh * 320;
#pragma unroll
  for (int e = 0; e < 4; ++e) {
    const int gh = 4 * G + e;
    const float lv = __shfl(ls, gh & 15);
    if (gh < 5) {
      const float inv = 1.f / lv;
#pragma unroll
      for (int nt = 0; nt < 4; ++nt) Oo[gh * 64 + nt * 16 + g] = f2bf(O[nt][e] * inv);
    }
  }
}
__device__ __forceinline__ void phase_sparse(const Params& p, char* smem, int bid, int nblk) {
  const int tid = fresh_tid(), wid = tid >> 6, g = tid & 15;
  char* wbase = smem + wid * 8192;
  const bool aff = (nblk & 7) == 0;
  const int grp = bid & 7, j = bid >> 3, nj = nblk >> 3;
  int it = aff ? j * 4 + wid : bid * 4 + wid;
  const int step = aff ? nj * 4 : nblk * 4, lim = aff ? S_ : NTOK * 2;
  auto dec = [&](int i, int& b, int& kvh, int& q) { if (aff) { b = grp >> 1; kvh = grp & 1; q = i; } else { b = i >> 14; kvh = (i >> 13) & 1; q = i & 8191; } };
  if (it >= lim) return;
  int b, kvh, q; dec(it, b, kvh, q);
  int kraw[16];
  { const u16* sel = (const u16*)(p.ws + O_SEL) + (size_t)(b * S_ + q) * NSEL;
#pragma unroll
    for (int i = 0; i < 16; ++i) kraw[i] = (int)sel[16 * i + g]; }
  int cnt = ((const int*)(p.ws + O_SELCNT))[b * S_ + q];
  while (true) {
    const int itn = it + step; const bool hn = itn < lim;
    int bn = b, kvhn = kvh, qn = q; if (hn) dec(itn, bn, kvhn, qn);
    sparse_item(p, wbase, b, kvh, q, kraw, cnt, hn && bn == b, qn);
    if (!hn) break;
    if (bn != b) {
      const u16* sel = (const u16*)(p.ws + O_SEL) + (size_t)(bn * S_ + qn) * NSEL;
#pragma unroll
      for (int i = 0; i < 16; ++i) kraw[i] = (int)sel[16 * i + g];
      cnt = ((const int*)(p.ws + O_SELCNT))[bn * S_ + qn];
    }
    it = itn; b = bn; kvh = kvhn; q = qn;
  }
}

#define PHASE_KERNEL(name, body) \
  __global__ void __launch_bounds__(THREADS, 2) name(Params p) { \
    __shared__ __attribute__((aligned(16))) char smem[SMEM_BYTES]; \
    const int bid = blockIdx.x, nblk = gridDim.x; (void)smem; (void)bid; (void)nblk; body; }

PHASE_KERNEL(k_prep, (phase_prep(p, smem, bid, nblk, false), phase_prep(p, smem, bid, nblk, true)))
PHASE_KERNEL(k_norm1, phase_norm(p, p.x, p.g_mix, 0, 1, false, bid, nblk))
PHASE_KERNEL(k_proj, phase_proj(p, smem, bid, nblk))
PHASE_KERNEL(k_indexer, phase_indexer(p, smem, bid, nblk))
PHASE_KERNEL(k_dilated, phase_dilated(p, smem, bid, nblk))
PHASE_KERNEL(k_sparse, phase_sparse(p, smem, bid, nblk))
PHASE_KERNEL(k_dilcomb, phase_dil_combine(p, bid, nblk))
PHASE_KERNEL(k_outproj, phase_outproj(p, smem, bid, nblk))
PHASE_KERNEL(k_norm2, phase_norm(p, p.out, p.g_ffn, 3, 4, true, bid, nblk))
PHASE_KERNEL(k_router, phase_router_sgu(p, smem, bid, nblk))
PHASE_KERNEL(k_route, phase_route_sdown(p, smem, bid, nblk))
PHASE_KERNEL(k_dispatch, phase_dispatch(p, smem, bid, nblk))
PHASE_KERNEL(k_moeup, phase_moe_up(p, smem, bid, nblk))
PHASE_KERNEL(k_moedown, phase_moe_down(p, smem, bid, nblk))
PHASE_KERNEL(k_combine, phase_combine(p, bid, nblk))

#if DEBUG_MODE == 1
__device__ float dbg_enc(float x, float base) { return base * (1.f + 9.f * fminf(1.f, log2f(1.f + x) / 20.f)); }
__global__ void k_debug_emit(Params p) {
  const u32* d = (const u32*)(p.ws + O_DBG);
  const float v1 = dbg_enc((float)d[DBG_X1], 1e6f), v2 = dbg_enc((float)d[DBG_X2], 1e5f);
  for (int i = blockIdx.x * blockDim.x + fresh_tid(); i <= 1000000; i += gridDim.x * blockDim.x) p.out[i] = i == 0 ? v1 : v2;
}
#endif

#define XB_TMO      128
#define XB_XCNT(j)  (256  + 64 * (j))
#define XB_XSUB(j)  (1280 + 64 * (j))
#define XB_XGEN(j)  (2304 + 64 * (j))
#define XB_TOP      3328
#define XB_TOPGEN   3392
#define XB_SPIN_CAP (1u << 22)
DI u32 xb_ld(u32* p) { return __hip_atomic_load(p, __ATOMIC_RELAXED, __HIP_MEMORY_SCOPE_AGENT); }
DI u32 xb_add(u32* p, u32 v) { return __hip_atomic_fetch_add(p, v, __ATOMIC_RELAXED, __HIP_MEMORY_SCOPE_AGENT); }
DI u32 xb_xcc_id() { return (u32)__builtin_amdgcn_s_getreg((3 << 11) | 20) & 0xFu; }
#define XB_SPIN(cond, bar) do { u32 _sp = 0; while (cond) { __builtin_amdgcn_s_sleep(1); \
    if ((++_sp & 255u) == 0u) { if (xb_ld(&(bar)[XB_TMO])) break; if (_sp > XB_SPIN_CAP) { atomicAdd(&(bar)[XB_TMO], 1u); break; } } } } while (0)
struct XcdBarrier { u32* bar; u32 x; volatile LDS_AS u32* st; };
DI XcdBarrier xcd_barrier_post(u32* bar, volatile LDS_AS u32* st) {
  XcdBarrier b; b.bar = bar; b.x = xb_xcc_id(); b.st = st;
  if (threadIdx.x == 0) (void)xb_add(&bar[XB_XCNT(b.x)], 1u);
  return b;
}
DI void xcd_barrier_complete(u32* bar, u32 x, u32& nloc, u32& nx) {
  const u32 G = gridDim.x;
  u32 sum, cnt, mine, sp = 0u;
  for (;;) {
    sum = 0u; cnt = 0u; mine = 0u;
#pragma unroll
    for (u32 j = 0; j < 16; ++j) { const u32 c = xb_ld(&bar[XB_XCNT(j)]); sum += c; cnt += (c > 0u) ? 1u : 0u; mine = (j == x) ? c : mine; }
    if (sum == G) break;
    __builtin_amdgcn_s_sleep(1);
    if ((++sp & 255u) == 0u) { if (xb_ld(&bar[XB_TMO])) break; if (sp > XB_SPIN_CAP) { atomicAdd(&bar[XB_TMO], 1u); break; } }
  }
  nloc = mine > 0u ? mine : 1u; nx = cnt > 0u ? cnt : 1u;
}
DI void xcd_barrier(const XcdBarrier& b) {
  asm volatile("s_waitcnt vmcnt(0)" ::: "memory");
  __syncthreads();
  if (threadIdx.x == 0) {
    u32* bar = b.bar;
    __builtin_amdgcn_s_waitcnt(0);
    u32 nloc = b.st[0], nx = b.st[1];
    if (nloc == 0u) { xcd_barrier_complete(bar, b.x, nloc, nx); b.st[0] = nloc; b.st[1] = nx; }
    const u32 old = xb_add(&bar[XB_XSUB(b.x)], 1u);
    const u32 gen = old / nloc;
    if (old + 1u == (gen + 1u) * nloc) {
      __builtin_amdgcn_fence(__ATOMIC_RELEASE, "agent");
      asm volatile("s_waitcnt vmcnt(0)" ::: "memory");
      const u32 og = xb_add(&bar[XB_TOP], 1u);
      const u32 tg = og / nx;
      if (og + 1u == (tg + 1u) * nx) xb_add(&bar[XB_TOPGEN], 1u);
      else XB_SPIN(xb_ld(&bar[XB_TOPGEN]) == tg, bar);
      __builtin_amdgcn_fence(__ATOMIC_ACQUIRE, "agent");
      xb_add(&bar[XB_XGEN(b.x)], 1u);
      asm volatile("s_waitcnt vmcnt(0)" ::: "memory");
    } else {
      XB_SPIN(xb_ld(&bar[XB_XGEN(b.x)]) == gen, bar);
      __builtin_amdgcn_fence(__ATOMIC_ACQUIRE, "agent");
      asm volatile("s_waitcnt vmcnt(0)" ::: "memory");
    }
  }
  __syncthreads();
}

__global__ void __launch_bounds__(THREADS, 2) k_mega(Params p) {
  __shared__ __attribute__((aligned(16))) char smem[SMEM_BYTES + 16];
  cg::grid_group grid = cg::this_grid();
  const int bid = blockIdx.x, nblk = gridDim.x;
  volatile LDS_AS u32* st = (volatile LDS_AS u32*)(smem + SMEM_BYTES);
  if (threadIdx.x == 0) { st[0] = 0u; st[1] = 0u; }
  __syncthreads();
  const XcdBarrier xb = xcd_barrier_post((u32*)(p.ws + O_BAR), st);
  phase_prep(p, smem, bid, nblk, false);
  grid.sync();
  phase_norm(p, p.x, p.g_mix, 0, 1, false, bid, nblk);
  xcd_barrier(xb);
  phase_proj(p, smem, bid, nblk);
  xcd_barrier(xb);
  if (((bid >> 8) ^ bid) & 1) { phase_prep(p, smem, bid, nblk, true); phase_indexer(p, smem, bid, nblk); }
  else { phase_indexer(p, smem, bid, nblk); phase_prep(p, smem, bid, nblk, true); }
  xcd_barrier(xb);
  phase_sparse(p, smem, bid, nblk);
  phase_dilated(p, smem, bid, nblk);
  xcd_barrier(xb);
  phase_dil_combine(p, bid, nblk);
  xcd_barrier(xb);
  phase_outproj(p, smem, bid, nblk);
  xcd_barrier(xb);
  phase_norm(p, p.out, p.g_ffn, 3, 4, true, bid, nblk);
  xcd_barrier(xb);
  phase_router_sgu(p, smem, bid, nblk);
  xcd_barrier(xb);
  phase_route_sdown(p, smem, bid, nblk);
  xcd_barrier(xb);
  phase_dispatch(p, smem, bid, nblk);
  xcd_barrier(xb);
  phase_moe_up(p, smem, bid, nblk);
  xcd_barrier(xb);
  phase_moe_down(p, smem, bid, nblk);
  xcd_barrier(xb);
  phase_combine(p, bid, nblk);
}
#if DEBUG_MODE == 2
__global__ void k_debug_copy(Params p) {
  for (size_t i = blockIdx.x * (size_t)blockDim.x + fresh_tid(); i < (size_t)NTOK * 1024; i += (size_t)gridDim.x * blockDim.x) {
#if DBG_BUF == 0
    p.out[i] = ((i & 1023) >= 640) ? bf2f(((const u16*)(p.ws + O_O))[i]) : 0.f;
#elif DBG_BUF == 4
    { const size_t t = i >> 10; const int c = (int)(i & 1023);
      p.out[i] = c < 384 ? bf2f(((const u16*)(p.ws + O_QB))[t * 384 + c]) : c < 768 ? bf2f(((const u16*)(p.ws + O_KB))[t * 384 + c - 384]) : bf2f(((const u16*)(p.ws + O_VB))[t * 384 + c - 768]); }
#elif DBG_BUF == 8
    { const size_t t = i >> 10; const int c = (int)(i & 1023);
      p.out[i] = c < 384 ? bf2f(((const u16*)(p.ws + O_QB))[t * 384 + c]) : c < 768 ? bf2f(((const u16*)(p.ws + O_KB))[t * 384 + c - 384]) : 0.f; }
#elif DBG_BUF == 5
    { const size_t t = i >> 10; const int c = (int)(i & 1023);
      p.out[i] = c < 384 ? bf2f(((const u16*)(p.ws + O_DNUM))[t * 384 + c]) : c < 768 ? bf2f(((const u16*)(p.ws + O_DNUM))[((size_t)NTOK + t) * 384 + c - 384]) : c < 780 ? ((const float*)(p.ws + O_DML))[t * 12 + c - 768] : 0.f; }
#elif DBG_BUF == 6
    p.out[i] = bf2f(((const u16*)(p.ws + O_H))[(i >> 10) * 2048 + (i & 1023)]);
#elif DBG_BUF == 7
    {
      if (i < 2097152) p.out[i] = ((const float*)(p.ws + O_ROPE))[i];
      else p.out[i] = 0.f; }
#elif DBG_BUF == 1
    p.out[i] = (float)((const u16*)(p.ws + O_SEL))[i % ((size_t)NTOK * 256)];
#elif DBG_BUF == 2
    p.out[i] = bf2f(((const u16*)(p.ws + O_H))[(i >> 10) * 2048 + (i & 1023)]);
#elif DBG_BUF == 3
    p.out[i] = ((const float*)(p.ws + O_LOGITS))[i % ((size_t)NTOK * 256)];
#endif
  }
}
#endif

#if DEBUG_MODE == 3
__global__ void k_check_kb(Params p) {
  const int lane = fresh_tid() & 63, wid = fresh_tid() >> 6;
  const u16* H = (const u16*)(p.ws + O_H); const u16* W = (const u16*)(p.ws + O_WT_IN);
  const u16* KB = (const u16*)(p.ws + O_KB); const float2* rope = (const float2*)(p.ws + O_ROPE);
  u32* dbg = (u32*)(p.ws + O_DBG);
  for (int row = blockIdx.x * 4 + wid; row < NTOK * 6; row += gridDim.x * 4) {
    const int tok = row / 6, hd = row % 6;
    const u16* hr = H + (size_t)tok * 2048; const u16* wr = W + (size_t)(1856 + hd * 64 + lane) * 1024;
    float a = 0.f;
    for (int k = 0; k < 1024; k += 8) {
      const u32x4 hv = *(const u32x4*)(hr + k), wv = *(const u32x4*)(wr + k);
#pragma unroll
      for (int e = 0; e < 4; ++e) { a += __uint_as_float(hv[e] << 16) * __uint_as_float(wv[e] << 16); a += __uint_as_float(hv[e] & 0xffff0000u) * __uint_as_float(wv[e] & 0xffff0000u); }
    }
    const float ss = wave_sum(a * a);
    float v = a * rsqrtf(ss * (1.f / 64.f) + EPS_) * p.knb[lane];
    const float o = __shfl_xor(v, 32);
    const float2 cs = rope[tok * 32 + (lane & 31)];
    v = lane < 32 ? v * cs.x - o * cs.y : v * cs.x + o * cs.y;
    const float got = bf2f(KB[(size_t)tok * 384 + hd * 64 + lane]);
    const bool bad = fabsf(got - v) > 0.03f + 0.02f * fabsf(v);
    const unsigned long long m = __ballot(bad);
    if (m && lane == 0) { atomicAdd(dbg + 4, 1u); const int pc = __popcll(m); if (pc >= 48) atomicAdd(dbg + 6, 1u); else if (pc <= 8) atomicAdd(dbg + 7, 1u); else atomicAdd(dbg + 8, 1u); }
  }
}
__global__ void k_check_emit(Params p) {
  const u32* d = (const u32*)(p.ws + O_DBG);
  const u32 cnt = d[4];
  const int bits1 = (cnt > 0) + 2 * (cnt > 3) + 4 * (cnt > 10) + 8 * (cnt > 30) + 16 * (cnt > 100) + 32 * (cnt > 1000);
  const int bits2 = (d[6] > 0) + 2 * (d[7] > 0) + 4 * (d[8] > 0) + 8 * (d[6] > d[7] + d[8]);
  const float c1 = (float)(10 + bits1), c2 = (float)(10 + bits2);
  const float v1 = c1 * 1e5f, v2 = c2 * 1e4f;
  for (int i = blockIdx.x * blockDim.x + fresh_tid(); i <= 1000000; i += gridDim.x * blockDim.x) p.out[i] = i == 0 ? v1 : v2;
}
#endif

#if DEBUG_MODE == 4
__global__ void k_check_sel(Params p) {
  const int tid = threadIdx.x;
  const u16* QI = (const u16*)(p.ws + O_QI); const u16* KI = (const u16*)(p.ws + O_KI); const float* WI = (const float*)(p.ws + O_WI);
  const u16* SEL = (const u16*)(p.ws + O_SEL); const int* SELCNT = (const int*)(p.ws + O_SELCNT);
  u32* dbg = (u32*)(p.ws + O_DBG);
  float* scr = (float*)(p.ws + O_LOGITS) + (size_t)blockIdx.x * 8192;
  __shared__ int s_bad;
  for (int sidx = blockIdx.x; sidx < 1024; sidx += gridDim.x) {
    const int b = sidx & 3, t = ((int)(((long long)(sidx >> 2) * 8191) / 255) & ~7) + DBG_TMOD, tok = b * S_ + t;
    if (tid == 0) s_bad = 0;
    __syncthreads();
    for (int k = tid; k <= t; k += blockDim.x) {
      float sc = 0.f;
      for (int h = 0; h < 8; ++h) {
        float d = 0.f;
        for (int e = 0; e < 64; ++e) d += bf2f(QI[(size_t)tok * 512 + h * 64 + e]) * bf2f(KI[(size_t)(b * S_ + k) * 64 + e]);
        sc += WI[tok * 8 + h] * fmaxf(d, 0.f);
      }
      scr[k] = sc;
    }
    __syncthreads();
    const int cnt = SELCNT[tok], want = min(t + 1, NSEL);
    int bad = 0;
    if (tid == 0 && cnt != want) atomicAdd(dbg + 6, 1u);
    if (tid < cnt && tid < NSEL) {
      const int key = SEL[(size_t)tok * NSEL + tid];
      if (key > t) bad += 1;
      else {
        const float sk = scr[key]; int rank = 0;
        for (int k = 0; k <= t; ++k) rank += (scr[k] > sk || (scr[k] == sk && k < key)) ? 1 : 0;
        if (rank >= NSEL + 2) { bad += 1; atomicMax(dbg + 7, (u32)rank); }
        for (int j = 0; j < tid; ++j) if (SEL[(size_t)tok * NSEL + j] == key) { bad += 1; break; }
      }
    }
    if (bad) atomicAdd(&s_bad, bad);
    __syncthreads();
    if (tid == 0 && s_bad) { atomicAdd(dbg + 4, (u32)s_bad); atomicAdd(dbg + 5, 1u); }
    __syncthreads();
  }
}
__device__ float dbg_enc2(float x, float base) { return base * (1.f + 9.f * fminf(1.f, log2f(1.f + x) / 20.f)); }
__global__ void k_check_emit4(Params p) {
  const u32* d = (const u32*)(p.ws + O_DBG);
  const float v1 = dbg_enc2((float)d[7], 1e6f), v2 = dbg_enc2((float)d[4], 1e5f);
  for (int i = blockIdx.x * blockDim.x + threadIdx.x; i < NTOK * 1024; i += gridDim.x * blockDim.x) p.out[i] = i == 0 ? v1 : (i <= 1000000 ? v2 : 0.f);
}
#endif
extern "C" void kernel_launch(void* const* d_in, const int* in_sizes, int n_in, void* d_out, int out_size, void* d_ws, size_t ws_size,
                              hipStream_t stream) {
  Params p{};
  p.x = (const float*)d_in[0]; p.c = (const float*)d_in[1]; p.pos = (const int*)d_in[2];
  p.w_ada = (const float*)d_in[3]; p.b_ada = (const float*)d_in[4]; p.g_mix = (const float*)d_in[5]; p.w_in = (const float*)d_in[6];
  p.qna = (const float*)d_in[7]; p.kna = (const float*)d_in[8]; p.qnb = (const float*)d_in[9]; p.knb = (const float*)d_in[10];
  p.w_out = (const float*)d_in[11]; p.g_ffn = (const float*)d_in[12]; p.w_router = (const float*)d_in[13]; p.rbias = (const float*)d_in[14];
  p.w_gate = (const float*)d_in[15]; p.w_up = (const float*)d_in[16]; p.w_down = (const float*)d_in[17];
  p.ws_gate = (const float*)d_in[18]; p.ws_up = (const float*)d_in[19]; p.ws_down = (const float*)d_in[20];
  p.out = (float*)d_out; p.ws = (char*)d_ws;
  if (ws_size < WS_TOTAL) { fprintf(stderr, "workspace too small: %zu < %zu\n", ws_size, (size_t)WS_TOTAL); return; }
  (void)hipMemsetAsync(d_ws, 0, ZERO_BYTES, stream);
#if MEGA && DEBUG_MODE != 4 && DEBUG_MODE != 5
  static int grid_blocks = 0;
  if (!grid_blocks) {
    int dev = 0, cus = 0, per_cu = 0;
    (void)hipGetDevice(&dev);
    (void)hipDeviceGetAttribute(&cus, hipDeviceAttributeMultiprocessorCount, dev);
    (void)hipOccupancyMaxActiveBlocksPerMultiprocessor(&per_cu, k_mega, THREADS, 0);
    if (per_cu > 2) per_cu = 2;
    grid_blocks = cus * per_cu;
    grid_blocks -= grid_blocks % 8;
  }
  void* args[] = {&p};
  hipError_t e = hipLaunchCooperativeKernel((void*)k_mega, dim3(grid_blocks), dim3(THREADS), args, 0, stream);
  if (e != hipSuccess) fprintf(stderr, "cooperative launch failed: %s (grid %d)\n", hipGetErrorString(e), grid_blocks);
#else
  const dim3 g(2048), t(THREADS);
  k_prep<<<g, t, 0, stream>>>(p);
  k_norm1<<<g, t, 0, stream>>>(p);
  k_proj<<<g, t, 0, stream>>>(p);
  k_indexer<<<dim3(1024), t, 0, stream>>>(p);
#if DEBUG_MODE == 4
  k_check_sel<<<512, 256, 0, stream>>>(p); k_check_emit4<<<256, 256, 0, stream>>>(p); return;
#endif
  k_dilated<<<g, t, 0, stream>>>(p);
  k_sparse<<<g, t, 0, stream>>>(p);
  k_dilcomb<<<g, t, 0, stream>>>(p);
  k_outproj<<<g, t, 0, stream>>>(p);
  k_norm2<<<g, t, 0, stream>>>(p);
  k_router<<<g, t, 0, stream>>>(p);
  k_route<<<g, t, 0, stream>>>(p);
  k_dispatch<<<g, t, 0, stream>>>(p);
  k_moeup<<<g, t, 0, stream>>>(p);
  k_moedown<<<g, t, 0, stream>>>(p);
  k_combine<<<g, t, 0, stream>>>(p);
#endif
}
```

```cpp
#include <hip/hip_runtime.h>
#include <hip/hip_cooperative_groups.h>
#include <stdint.h>
#include <stdio.h>
namespace cg = cooperative_groups;

typedef unsigned short u16;
typedef unsigned int u32;
typedef unsigned long long u64;
typedef __attribute__((ext_vector_type(8))) short bf16x8;
typedef __attribute__((ext_vector_type(4))) short s16x4;
typedef __attribute__((ext_vector_type(4))) float f32x4;
typedef __attribute__((ext_vector_type(16))) float f32x16;
typedef __attribute__((ext_vector_type(2))) float f32x2;
typedef __attribute__((ext_vector_type(4))) u32 u32x4;
typedef __attribute__((ext_vector_type(2))) u32 u32x2;
typedef __attribute__((ext_vector_type(2))) __bf16 bf16x2_t;
#define DI __device__ __forceinline__
#define LDS_AS __attribute__((address_space(3)))

#ifndef MEGA
#define MEGA 1
#endif
#ifndef DEBUG_MODE
#define DEBUG_MODE 0
#endif
#define DBG_TMOD 0
#define DBG_SUB 0
#define DBG_BUF 8
#define DBG_X1 2
#define DBG_X2 1
constexpr int NB_ = 4, S_ = 8192, D_ = 1024, NTOK = NB_ * S_;
constexpr int DIN_PAD = 2688;
constexpr int NEXP = 256, TOPK = 8, DEXP = 256;
constexpr int NSLOT = NTOK * TOPK;
constexpr float EPS_ = 1e-6f;
constexpr int NSEL = 256;
constexpr int THREADS = 256;
constexpr int SMEM_BYTES = 80384;

constexpr size_t al256(size_t x) { return (x + 255) & ~size_t(255); }
constexpr size_t O_CNT = 0;
constexpr size_t O_KMAX = 1024;
constexpr size_t O_DBG = 2048;
constexpr size_t O_BAR = 4096;
constexpr size_t ZERO_BYTES = 32768;
constexpr size_t O_MOD = 32768;
constexpr size_t O_WT_IN = O_MOD + al256(4 * 6144 * 4);
constexpr size_t O_WT_OUT = O_WT_IN + (size_t)DIN_PAD * 1024 * 2;
constexpr size_t O_WT_RT = O_WT_OUT + (size_t)1024 * 1024 * 2;
constexpr size_t O_WT_SGU = O_WT_RT + (size_t)256 * 3072 * 2;
constexpr size_t O_WT_SD = O_WT_SGU + (size_t)512 * 1024 * 2;
constexpr size_t O_ROPE = O_WT_SD + (size_t)1024 * 256 * 2;
constexpr size_t O_SELE = O_ROPE + (size_t)NTOK * 32 * 8;
constexpr size_t O_GATE = O_SELE + (size_t)NTOK * 8 * 4;
constexpr size_t O_POSE = O_GATE + (size_t)NTOK * 8 * 4;
constexpr size_t O_TOKSLOT = O_POSE + (size_t)NTOK * 8 * 4;
constexpr size_t O_SLOTTOK = O_TOKSLOT + (size_t)NTOK * 8 * 4;
constexpr size_t O_SLOTGATE = O_SLOTTOK + (size_t)NSLOT * 4;
constexpr size_t O_SELCNT = O_SLOTGATE + (size_t)NSLOT * 4;
constexpr size_t O_LOGITS = O_SELCNT + (size_t)NTOK * 4;
constexpr size_t O_ACTS = O_LOGITS + (size_t)NTOK * 256 * 4;
constexpr size_t O_WT_ED = O_ACTS + (size_t)NTOK * 256 * 2;
constexpr size_t O_O = O_WT_ED + (size_t)NEXP * 1024 * 256 * 2;
constexpr size_t O_DNUM = O_O + (size_t)NTOK * 1024 * 2;
constexpr size_t O_DML = O_DNUM + (size_t)3 * NTOK * 384 * 2;
constexpr size_t O_ACT = O_DML + (size_t)3 * NTOK * 6 * 2 * 4;
constexpr size_t O_QB = O_ACT;
constexpr size_t O_KB = O_QB + (size_t)NTOK * 384 * 2;
constexpr size_t O_VB = O_KB + (size_t)NTOK * 384 * 2;
constexpr size_t O_SEL = O_VB + (size_t)NTOK * 384 * 2;
constexpr size_t O_BIG = O_ACT + (size_t)NSLOT * 256 * 2;
constexpr size_t O_WT_EGU = O_BIG;
constexpr size_t O_H = O_WT_EGU + (size_t)NEXP * 512 * 1024 * 2;
constexpr size_t O_QA = O_H + (size_t)NTOK * 2048 * 2;
constexpr size_t O_KV = O_QA + (size_t)NTOK * 640 * 2;
constexpr size_t O_QI = O_KV + (size_t)NTOK * 256 * 2;
constexpr size_t O_KI = O_QI + (size_t)NTOK * 512 * 2;
constexpr size_t O_WI = O_KI + (size_t)NTOK * 64 * 2;
constexpr size_t O_BIG_USED = O_WI + (size_t)NTOK * 8 * 4;
constexpr size_t WS_TOTAL = O_BIG + (size_t)NSLOT * 1024 * 2;
static_assert(O_BIG_USED <= WS_TOTAL, "overlay too large");
static_assert(O_SEL + (size_t)NTOK * 256 * 2 <= O_BIG, "act overlay too large");

struct Params {
  const float *x, *c; const int* pos;
  const float *w_ada, *b_ada, *g_mix, *w_in, *qna, *kna, *qnb, *knb, *w_out, *g_ffn, *w_router, *rbias,
              *w_gate, *w_up, *w_down, *ws_gate, *ws_up, *ws_down;
  float* out; char* ws;
};

DI int fresh_tid() { int t = threadIdx.x; asm volatile("" : "+v"(t)); return t; }
DI float bf2f(u16 h) { return __uint_as_float(((u32)h) << 16); }
DI u16 f2bf(float f) { return __builtin_bit_cast(u16, (__bf16)f); }
DI u32 pack2(float a, float b) { f32x2 v = {a, b}; return __builtin_bit_cast(u32, __builtin_convertvector(v, bf16x2_t)); }
DI bf16x8 pack8(float a0, float a1, float a2, float a3, float a4, float a5, float a6, float a7) {
  u32x4 p = {pack2(a0, a1), pack2(a2, a3), pack2(a4, a5), pack2(a6, a7)};
  return __builtin_bit_cast(bf16x8, p);
}
DI float wave_sum(float v) { for (int o = 32; o > 0; o >>= 1) v += __shfl_xor(v, o); return v; }
#define DPP_ADD(v, ctrl) ((v) + __builtin_bit_cast(float, __builtin_amdgcn_update_dpp(0, __builtin_bit_cast(int, (v)), (ctrl), 0xf, 0xf, true)))
DI float row16_sum(float v) {
  v = DPP_ADD(v, 0xB1);
  v = DPP_ADD(v, 0x4E);
  v = DPP_ADD(v, 0x141);
  v = DPP_ADD(v, 0x140);
  return v;
}
DI float silu_f(float v) { return v / (1.f + __expf(-v)); }
DI float sigmoid_f(float v) { return 1.f / (1.f + __expf(-v)); }
DI void glds16(const void* g, void* l) {
  __builtin_amdgcn_global_load_lds((const u32*)g, (LDS_AS u32*)l, 16, 0, 0);
}
#define MFMA16(a, b, c) __builtin_amdgcn_mfma_f32_16x16x32_bf16((a), (b), (c), 0, 0, 0)
#define MFMA32(a, b, c) __builtin_amdgcn_mfma_f32_32x32x16_bf16((a), (b), (c), 0, 0, 0)
DI s16x4 tr_read(const void* l) { return __builtin_amdgcn_ds_read_tr16_b64_v4i16((LDS_AS s16x4*)l); }

DI int rowmap(int mode, int n) {
  if (mode == 1) return n < 1472 ? n : (n < 1480 ? n - 1472 + 2624 : n - 8);
  if (mode == 2) return 64 * (n >> 5) + (n & 31);
  if (mode == 3) return 64 * (n >> 5) + (n & 31) + 32;
  return n;
}
__device__ __forceinline__ void transpose_tiles4(char* smem, const float* src, int ldn, int nvalid, int ntn, int t0, u16* dst, int ldk, int mode) {
  const int tid = fresh_tid();
  float4 v[4][4];
#pragma unroll
  for (int q = 0; q < 4; ++q) {
    const int t = t0 + q, k0 = (t / ntn) * 64, n0 = (t % ntn) * 64;
#pragma unroll
    for (int i = 0; i < 4; ++i) {
      const int k = (tid >> 4) + 16 * i, n = (tid & 15) * 4;
      v[q][i] = make_float4(0.f, 0.f, 0.f, 0.f);
      if (n0 + n + 3 < nvalid) v[q][i] = *(const float4*)(src + (size_t)(k0 + k) * ldn + n0 + n);
      else { float tt[4] = {0.f, 0.f, 0.f, 0.f};
        for (int e = 0; e < 4; ++e) if (n0 + n + e < nvalid) tt[e] = src[(size_t)(k0 + k) * ldn + n0 + n + e];
        v[q][i] = make_float4(tt[0], tt[1], tt[2], tt[3]); }
    }
  }
  __syncthreads();
#pragma unroll
  for (int q = 0; q < 4; ++q) {
    float* tile = (float*)smem + q * (64 * 65);
#pragma unroll
    for (int i = 0; i < 4; ++i) {
      const int k = (tid >> 4) + 16 * i, n = (tid & 15) * 4;
      tile[k * 65 + n] = v[q][i].x; tile[k * 65 + n + 1] = v[q][i].y; tile[k * 65 + n + 2] = v[q][i].z; tile[k * 65 + n + 3] = v[q][i].w;
    }
  }
  __syncthreads();
  const int nr = tid >> 2, ks = (tid & 3) * 16;
#pragma unroll
  for (int q = 0; q < 4; ++q) {
    const int t = t0 + q, k0 = (t / ntn) * 64, n0 = (t % ntn) * 64;
    const float* tile = (const float*)smem + q * (64 * 65);
    if (n0 + nr < nvalid) {
      float f[16];
#pragma unroll
      for (int j = 0; j < 16; ++j) f[j] = tile[(ks + j) * 65 + nr];
      const u32x4 lo4 = (u32x4){pack2(f[0], f[1]), pack2(f[2], f[3]), pack2(f[4], f[5]), pack2(f[6], f[7])};
      const u32x4 hi4 = (u32x4){pack2(f[8], f[9]), pack2(f[10], f[11]), pack2(f[12], f[13]), pack2(f[14], f[15])};
      u16* d = dst + (size_t)rowmap(mode, n0 + nr) * ldk + k0 + ks;
      *(u32x4*)d = lo4; *(u32x4*)(d + 8) = hi4;
      if (mode == 4) {
        float g[16];
#pragma unroll
        for (int j = 0; j < 16; ++j) g[j] = f[j] - bf2f(f2bf(f[j]));
        const u32x4 l0 = (u32x4){pack2(g[0], g[1]), pack2(g[2], g[3]), pack2(g[4], g[5]), pack2(g[6], g[7])};
        const u32x4 l1 = (u32x4){pack2(g[8], g[9]), pack2(g[10], g[11]), pack2(g[12], g[13]), pack2(g[14], g[15])};
        *(u32x4*)(d + 1024) = l0; *(u32x4*)(d + 1024 + 8) = l1;
        *(u32x4*)(d + 2048) = lo4; *(u32x4*)(d + 2048 + 8) = hi4;
      }
    }
  }
}

constexpr int PREP_T_IN = 16 * 42 / 4, PREP_T_OUT = 256 / 4, PREP_T_RT = 64 / 4, PREP_T_SG = 64 / 4, PREP_T_SU = 64 / 4, PREP_T_SD = 64 / 4;
constexpr int PREP_T_E = NEXP * 64 / 4;
constexpr int PREP_B0 = 0, PREP_B1 = PREP_B0 + PREP_T_IN, PREP_B2 = PREP_B1 + PREP_T_OUT, PREP_B3 = PREP_B2 + PREP_T_RT,
              PREP_B4 = PREP_B3 + PREP_T_SG, PREP_B5 = PREP_B4 + PREP_T_SU, PREP_B6 = PREP_B5 + PREP_T_SD,
              PREP_B7 = PREP_B6 + PREP_T_E, PREP_B8 = PREP_B7 + PREP_T_E, PREP_B9 = PREP_B8 + PREP_T_E;
constexpr int PREP_MOD = 96, PREP_ROPE = NTOK * 32 / 256, PREP_PAD = 1;
constexpr int PREP_ITEMS = PREP_B9 + PREP_MOD + PREP_ROPE + PREP_PAD;

__device__ __forceinline__ void phase_prep(const Params& p, char* smem, int bid, int nblk, bool experts) {
  char* ws = p.ws;
  const int tid = fresh_tid();
  for (int it = (experts ? PREP_B6 : 0) + bid; it < (experts ? PREP_B9 : PREP_ITEMS); it += nblk) {
    if (!experts && it >= PREP_B6 && it < PREP_B9) continue;
    if (it < PREP_B1) { transpose_tiles4(smem, p.w_in, 2632, 2632, 42, (it - PREP_B0) * 4, (u16*)(ws + O_WT_IN), 1024, 1); }
    else if (it < PREP_B2) { transpose_tiles4(smem, p.w_out, 1024, 1024, 16, (it - PREP_B1) * 4, (u16*)(ws + O_WT_OUT), 1024, 0); }
    else if (it < PREP_B3) { transpose_tiles4(smem, p.w_router, 256, 256, 4, (it - PREP_B2) * 4, (u16*)(ws + O_WT_RT), 3072, 4); }
    else if (it < PREP_B4) { transpose_tiles4(smem, p.ws_gate, 256, 256, 4, (it - PREP_B3) * 4, (u16*)(ws + O_WT_SGU), 1024, 2); }
    else if (it < PREP_B5) { transpose_tiles4(smem, p.ws_up, 256, 256, 4, (it - PREP_B4) * 4, (u16*)(ws + O_WT_SGU), 1024, 3); }
    else if (it < PREP_B6) { transpose_tiles4(smem, p.ws_down, 1024, 1024, 16, (it - PREP_B5) * 4, (u16*)(ws + O_WT_SD), 256, 0); }
    else if (it < PREP_B7) { const int t = it - PREP_B6, e = t >> 4;
      transpose_tiles4(smem, p.w_gate + (size_t)e * 1024 * 256, 256, 256, 4, (t & 15) * 4, (u16*)(ws + O_WT_EGU) + (size_t)e * 512 * 1024, 1024, 2); }
    else if (it < PREP_B8) { const int t = it - PREP_B7, e = t >> 4;
      transpose_tiles4(smem, p.w_up + (size_t)e * 1024 * 256, 256, 256, 4, (t & 15) * 4, (u16*)(ws + O_WT_EGU) + (size_t)e * 512 * 1024, 1024, 3); }
    else if (it < PREP_B9) { const int t = it - PREP_B8, e = t >> 4;
      transpose_tiles4(smem, p.w_down + (size_t)e * 256 * 1024, 1024, 1024, 16, (t & 15) * 4, (u16*)(ws + O_WT_ED) + (size_t)e * 1024 * 256, 256, 0); }
    else if (it < PREP_B9 + PREP_MOD) {
      const int n = (it - PREP_B9) * 64 + (tid & 63), kg = tid >> 6;
      float* sl = (float*)smem;
      __syncthreads();
      for (int i = tid; i < 4096; i += 256) sl[i] = silu_f(p.c[i]);
      __syncthreads();
      float a0 = 0.f, a1 = 0.f, a2 = 0.f, a3 = 0.f;
#pragma unroll 8
      for (int k = kg; k < 1024; k += 4) {
        float w = p.w_ada[(size_t)k * 6144 + n];
        a0 += sl[k] * w; a1 += sl[1024 + k] * w; a2 += sl[2048 + k] * w; a3 += sl[3072 + k] * w;
      }
      __syncthreads();
      float* ps = sl + 4096;
      ps[(kg * 4 + 0) * 64 + (tid & 63)] = a0; ps[(kg * 4 + 1) * 64 + (tid & 63)] = a1;
      ps[(kg * 4 + 2) * 64 + (tid & 63)] = a2; ps[(kg * 4 + 3) * 64 + (tid & 63)] = a3;
      __syncthreads();
      { const int b = tid >> 6, c = tid & 63;
        float s = p.b_ada[(it - PREP_B9) * 64 + c];
        for (int g = 0; g < 4; ++g) s += ps[(g * 4 + b) * 64 + c];
        ((float*)(ws + O_MOD))[b * 6144 + (it - PREP_B9) * 64 + c] = s; }
    }
    else if (it < PREP_B9 + PREP_MOD + PREP_ROPE) {
      const int idx = (it - PREP_B9 - PREP_MOD) * 256 + tid, tok = idx >> 5, i = idx & 31;
      const float inv = (float)exp(-(double)i * (9.210340371976184 / 32.0));
      const float ang = (float)p.pos[tok] * inv;
      double t = (double)ang * 0.15915494309189535; t -= rint(t);
      const float fr = (float)t;
      float2 cs = make_float2(__builtin_amdgcn_cosf(fr), __builtin_amdgcn_sinf(fr));
      ((float2*)(ws + O_ROPE))[idx] = cs;
    }
    else {
      u32* d = (u32*)((u16*)(ws + O_WT_IN) + (size_t)2632 * 1024);
      for (int i = tid; i < 56 * 512; i += 256) d[i] = 0u;
    }
  }
}

__device__ __forceinline__ void phase_norm(const Params& p, const float* src, const float* gain, int shc, int scc, bool write_lo, int bid, int nblk) {
  const int lane = fresh_tid() & 63, wid = fresh_tid() >> 6;
  const float* mod = (const float*)(p.ws + O_MOD);
  u16* H = (u16*)(p.ws + O_H);
  for (int it = bid; it < NTOK / 16; it += nblk) {
    for (int r = 0; r < 4; ++r) {
      const int tok = it * 16 + wid * 4 + r, b = tok >> 13;
      const float* xr = src + (size_t)tok * 1024;
      float4 v[4]; float ss = 0.f;
#pragma unroll
      for (int j = 0; j < 4; ++j) { v[j] = *(const float4*)(xr + lane * 4 + 256 * j); ss += v[j].x * v[j].x + v[j].y * v[j].y + v[j].z * v[j].z + v[j].w * v[j].w; }
      ss = wave_sum(ss);
      const float rstd = rsqrtf(ss * (1.f / 1024.f) + EPS_);
#pragma unroll
      for (int j = 0; j < 4; ++j) {
        const int col = lane * 4 + 256 * j;
        const float4 g = *(const float4*)(gain + col);
        const float4 sh = *(const float4*)(mod + b * 6144 + shc * 1024 + col);
        const float4 sc = *(const float4*)(mod + b * 6144 + scc * 1024 + col);
        float h0 = v[j].x * rstd * g.x * (1.f + sc.x) + sh.x, h1 = v[j].y * rstd * g.y * (1.f + sc.y) + sh.y;
        float h2 = v[j].z * rstd * g.z * (1.f + sc.z) + sh.z, h3 = v[j].w * rstd * g.w * (1.f + sc.w) + sh.w;
        u32x2 hi = {pack2(h0, h1), pack2(h2, h3)};
        *(u32x2*)(H + (size_t)tok * 2048 + col) = hi;
        if (write_lo) {
          float l0 = h0 - bf2f((u16)(hi[0] & 0xffff)), l1 = h1 - bf2f((u16)(hi[0] >> 16));
          float l2 = h2 - bf2f((u16)(hi[1] & 0xffff)), l3 = h3 - bf2f((u16)(hi[1] >> 16));
          u32x2 lo = {pack2(l0, l1), pack2(l2, l3)};
          *(u32x2*)(H + (size_t)tok * 2048 + 1024 + col) = lo;
        }
      }
    }
  }
}

struct GDesc { const u16* A; const u16* B; u32 aoffs[8]; u32 boff0, ldb; int split; };
template <class ARow>
DI GDesc g_make(const u16* A, ARow arow, const u16* B, int ldb, int split) {
  const int lane = fresh_tid() & 63, gsrc = (0x78 >> (2 * ((lane >> 4) & 3))) & 3;
  GDesc d; d.A = A; d.B = B; d.ldb = (u32)ldb; d.split = split;
#pragma unroll
  for (int i = 0; i < 8; ++i) d.aoffs[i] = (u32)arow(16 * i + (lane >> 2)) + ((lane & 3) ^ gsrc) * 8;
  d.boff0 = (u32)(lane >> 2) * (u32)ldb + ((lane & 3) ^ gsrc) * 8;
  return d;
}
DI void g_stage(char* smem, const GDesc& d, int t) {
  const int lane = fresh_tid() & 63;
  char* base = smem + (t & 3) * 16384 + lane * 16;
  const int ko = (d.split && t >= 32) ? t * 32 - 1024 : t * 32;
#pragma unroll
  for (int i = 0; i < 8; ++i) glds16(d.A + d.aoffs[i] + ko, base + i * 1024);
#pragma unroll
  for (int i = 0; i < 8; ++i) glds16(d.B + d.boff0 + (u32)(16 * i) * d.ldb + t * 32, base + 8192 + i * 1024);
}
DI void g_begin(char* smem, const GDesc& d, int nkt) {
  const int wid = __builtin_amdgcn_readfirstlane(fresh_tid() >> 6);
  __syncthreads();
  if (wid < 3 && wid < nkt) g_stage(smem, d, wid);
}
template <int ABL = 0>
DI void g_run(char* smem, const GDesc& d, int nkt, bool has_next, const GDesc& nx, f32x4 (&acc)[4][4]) {
  const int tid = fresh_tid(), lane = tid & 63, wid = __builtin_amdgcn_readfirstlane(tid >> 6), wr = wid >> 1, wc = wid & 1, fr = lane & 15, fq = lane >> 4;
  const int grd = (0x78 >> (2 * ((fr >> 2) & 3))) & 3, rdq = (fq ^ grd) * 16;
#pragma unroll
  for (int m = 0; m < 4; ++m)
#pragma unroll
    for (int n = 0; n < 4; ++n) acc[m][n] = (f32x4){0.f, 0.f, 0.f, 0.f};
  for (int t = 0; t < nkt; ++t) {
    if (wid == (t & 3)) asm volatile("s_waitcnt vmcnt(0)" ::: "memory");
    asm volatile("s_waitcnt lgkmcnt(0)" ::: "memory");
    __builtin_amdgcn_s_barrier();
    const int g = t + 3;
    if (!(ABL & 1) && wid == (g & 3)) { if (g < nkt) g_stage(smem, d, g); else if (has_next) g_stage(smem, nx, g - nkt); }
    const char* base = smem + (t & 3) * 16384;
    bf16x8 At[4], Bt[4];
#pragma unroll
    for (int m = 0; m < 4; ++m) At[m] = *(const bf16x8*)(base + (wr * 64 + m * 16 + fr) * 64 + rdq);
#pragma unroll
    for (int n = 0; n < 4; ++n) Bt[n] = *(const bf16x8*)(base + 8192 + (wc * 64 + n * 16 + fr) * 64 + rdq);
#pragma unroll
    for (int m = 0; m < 4; ++m)
#pragma unroll
      for (int n = 0; n < 4; ++n) acc[m][n] = MFMA16(Bt[n], At[m], acc[m][n]);
  }
}

struct G2Desc { const u16* A; const u16* B; u32 lda, ldb; int rmax; const u32* tab; int bperm; };
DI u32 g2_brow(int bperm, int i, int lr) {
  if (bperm == 1) return (u32)((i >> 2) * 64 + 16 * (lr >> 2) + 4 * (i & 3) + (lr & 3));
  if (bperm == 2) return (u32)((i >> 2) * 64 + 32 * ((i & 3) >> 1) + 8 * (lr >> 2) + 4 * (i & 1) + (lr & 3));
  return (u32)(16 * i + lr);
}
DI void g2_stage_half(char* smem, const G2Desc& d, int t, int slot, int half) {
  const int lane = fresh_tid() & 63, gsrc = (0x78 >> (2 * ((lane >> 4) & 3))) & 3, pc = ((lane & 3) ^ gsrc) * 8;
  char* base = smem + slot * 24576 + lane * 16;
  if (half == 0) {
#pragma unroll
    for (int i = 0; i < 12; ++i) {
      const int r = 16 * i + (lane >> 2);
      const u32 ro = d.tab ? d.tab[r] : (u32)min(r, d.rmax) * d.lda;
      glds16(d.A + ro + pc + t * 32, base + i * 1024);
    }
  } else {
#pragma unroll
    for (int i = 12; i < 16; ++i) {
      const int r = 16 * i + (lane >> 2);
      const u32 ro = d.tab ? d.tab[r] : (u32)min(r, d.rmax) * d.lda;
      glds16(d.A + ro + pc + t * 32, base + i * 1024);
    }
#pragma unroll
    for (int i = 0; i < 8; ++i) glds16(d.B + g2_brow(d.bperm, i, lane >> 2) * d.ldb + pc + t * 32, base + 16384 + i * 1024);
  }
}
template <int OFF> DI void ldsr(bf16x8& d, u32 a) { asm volatile("ds_read_b128 %0, %1 offset:%2" : "=v"(d) : "v"(a), "n"(OFF)); }
struct G2State { int g, slot; };
DI void g2_begin(char* smem, const G2Desc& d, int nkt, G2State& st) {
  const int wid = __builtin_amdgcn_readfirstlane(fresh_tid() >> 6);
  __syncthreads();
  st.g = 0; st.slot = 0;
  if ((wid >> 1) < nkt) g2_stage_half(smem, d, wid >> 1, wid >> 1, wid & 1);
}
DI void g2_rows(const G2Desc& d, int half, u32 (&ro)[12]) {
  const int lr = (fresh_tid() & 63) >> 2;
  if (half == 0) {
    if (d.tab) {
      const u32 ta = (u32)(uintptr_t)d.tab + (u32)lr * 4u;
      asm volatile("ds_read_b32 %0, %12\n ds_read_b32 %1, %12 offset:64\n ds_read_b32 %2, %12 offset:128\n ds_read_b32 %3, %12 offset:192\n"
                   "ds_read_b32 %4, %12 offset:256\n ds_read_b32 %5, %12 offset:320\n ds_read_b32 %6, %12 offset:384\n ds_read_b32 %7, %12 offset:448\n"
                   "ds_read_b32 %8, %12 offset:512\n ds_read_b32 %9, %12 offset:576\n ds_read_b32 %10, %12 offset:640\n ds_read_b32 %11, %12 offset:704\n"
                   "s_waitcnt lgkmcnt(0)"
                   : "=&v"(ro[0]), "=&v"(ro[1]), "=&v"(ro[2]), "=&v"(ro[3]), "=&v"(ro[4]), "=&v"(ro[5]), "=&v"(ro[6]), "=&v"(ro[7]),
                     "=&v"(ro[8]), "=&v"(ro[9]), "=&v"(ro[10]), "=&v"(ro[11]) : "v"(ta) : "memory");
    } else {
#pragma unroll
      for (int j = 0; j < 12; ++j) ro[j] = (u32)min(16 * j + lr, d.rmax) * d.lda;
    }
  } else {
    if (d.tab) {
      const u32 ta = (u32)(uintptr_t)d.tab + (u32)(192 + lr) * 4u;
      asm volatile("ds_read_b32 %0, %4\n ds_read_b32 %1, %4 offset:64\n ds_read_b32 %2, %4 offset:128\n ds_read_b32 %3, %4 offset:192\n"
                   "s_waitcnt lgkmcnt(0)"
                   : "=&v"(ro[0]), "=&v"(ro[1]), "=&v"(ro[2]), "=&v"(ro[3]) : "v"(ta) : "memory");
    } else {
#pragma unroll
      for (int j = 0; j < 4; ++j) ro[j] = (u32)min(192 + 16 * j + lr, d.rmax) * d.lda;
    }
#pragma unroll
    for (int j = 4; j < 12; ++j) ro[j] = g2_brow(d.bperm, j - 4, lr) * d.ldb;
  }
}
DI void g2_run(char* smem, const G2Desc& d, int nkt, bool has_next, const G2Desc& nx, f32x4 (&acc)[8][4], G2State& st) {
  const int tid = fresh_tid(), lane = tid & 63, wid = __builtin_amdgcn_readfirstlane(tid >> 6), wr = wid >> 1, wc = wid & 1, fr = lane & 15, fq = lane >> 4;
  const int grd = (0x78 >> (2 * ((fr >> 2) & 3))) & 3, rdq = (fq ^ grd) * 16;
  const int half = wid & 1, gsrc = (0x78 >> (2 * ((lane >> 4) & 3))) & 3;
  const u32 pc = (u32)(((lane & 3) ^ gsrc) * 8);
#pragma unroll
  for (int m = 0; m < 8; ++m)
#pragma unroll
    for (int n = 0; n < 4; ++n) acc[m][n] = (f32x4){0.f, 0.f, 0.f, 0.f};
  int g = st.g, slot = st.slot;
  u32 ro[12];
#pragma unroll
  for (int j = 0; j < 12; ++j) ro[j] = 0u;
  if ((wid >> 1) == (g & 1)) g2_rows(d, half, ro);
#pragma unroll 1
  for (int t = 0; t < nkt; ++t) {
    const bool mine = (wid >> 1) == (g & 1);
    if (mine) asm volatile("s_waitcnt vmcnt(0)" ::: "memory");
    asm volatile("s_waitcnt lgkmcnt(0)" ::: "memory");
    __builtin_amdgcn_s_barrier();
    const u32 la = (u32)(uintptr_t)smem + (u32)slot * 24576u + (u32)(fr * 64 + rdq);
    const u32 laB = la + 16384u + (u32)(wc * 4096), laA = la + (u32)(wr * 8192);
    bf16x8 Bt[4], At[8];
    ldsr<0>(Bt[0], laB); ldsr<1024>(Bt[1], laB); ldsr<2048>(Bt[2], laB); ldsr<3072>(Bt[3], laB);
    ldsr<0>(At[0], laA); ldsr<1024>(At[1], laA); ldsr<2048>(At[2], laA); ldsr<3072>(At[3], laA);
    ldsr<4096>(At[4], laA); ldsr<5120>(At[5], laA); ldsr<6144>(At[6], laA); ldsr<7168>(At[7], laA);
    const bool un = t + 2 >= nkt, son = mine && (!un || has_next);
    const int tt = un ? t + 2 - nkt : t + 2, s2 = slot >= 1 ? slot - 1 : 2;
    const u16* Aq = (un ? nx.A : d.A) + tt * 32;
    const u16* Bq = (un ? nx.B : d.B) + tt * 32;
    char* dq = smem + s2 * 24576 + half * 12288 + lane * 16;
#define G2_ISSUE(J) glds16(((half && (J) >= 4) ? Bq : Aq) + ro[J] + pc, dq + (J) * 1024)
#define G2_MMA(M) _Pragma("unroll") for (int n = 0; n < 4; ++n) acc[M][n] = MFMA16(Bt[n], At[M], acc[M][n]);
    __builtin_amdgcn_sched_barrier(0);
    asm volatile("s_waitcnt lgkmcnt(7)" : "+v"(Bt[0]), "+v"(Bt[1]), "+v"(Bt[2]), "+v"(Bt[3]), "+v"(At[0]));
    G2_MMA(0)
    if (son) { G2_ISSUE(0); G2_ISSUE(1); }
    __builtin_amdgcn_sched_barrier(0);
    asm volatile("s_waitcnt lgkmcnt(6)" : "+v"(At[1]));
    G2_MMA(1)
    if (son) { G2_ISSUE(2); G2_ISSUE(3); }
    __builtin_amdgcn_sched_barrier(0);
    asm volatile("s_waitcnt lgkmcnt(5)" : "+v"(At[2]));
    G2_MMA(2)
    if (son) { G2_ISSUE(4); G2_ISSUE(5); }
    __builtin_amdgcn_sched_barrier(0);
    asm volatile("s_waitcnt lgkmcnt(4)" : "+v"(At[3]));
    G2_MMA(3)
    if (son) { G2_ISSUE(6); G2_ISSUE(7); }
    __builtin_amdgcn_sched_barrier(0);
    asm volatile("s_waitcnt lgkmcnt(3)" : "+v"(At[4]));
    G2_MMA(4)
    if (son) { G2_ISSUE(8); }
    __builtin_amdgcn_sched_barrier(0);
    asm volatile("s_waitcnt lgkmcnt(2)" : "+v"(At[5]));
    G2_MMA(5)
    if (son) { G2_ISSUE(9); }
    __builtin_amdgcn_sched_barrier(0);
    asm volatile("s_waitcnt lgkmcnt(1)" : "+v"(At[6]));
    G2_MMA(6)
    if (son) { G2_ISSUE(10); }
    __builtin_amdgcn_sched_barrier(0);
    asm volatile("s_waitcnt lgkmcnt(0)" : "+v"(At[7]));
    G2_MMA(7)
    if (son) { G2_ISSUE(11); }
    __builtin_amdgcn_sched_barrier(0);
#undef G2_ISSUE
#undef G2_MMA
    if (!mine) {
      const bool un1 = t + 3 >= nkt;
      if (!un1) g2_rows(d, half, ro); else if (has_next && t + 1 < nkt) g2_rows(nx, half, ro);
    }
    ++g; slot = slot == 2 ? 0 : slot + 1;
  }
  st.g = g; st.slot = slot;
}

DI int xcd_item(int bid, int nblk, int k, int total) {
  const int x = bid & 7, v = bid >> 3, nv = nblk >> 3, per = (total + 7) >> 3;
  const int j = v + k * nv;
  if (j >= per) return -1;
  const int it = x * per + j;
  return it < total ? it : -1;
}
struct ARowLin { int ld; DI u32 operator()(int r) const { return (u32)r * (u32)ld; } };

template <int MR>
DI void epi_proj(const Params& p, f32x4 (&acc)[MR][4], int row0, int col0) {
  const int tid = fresh_tid(), lane = tid & 63, wid = tid >> 6, wr = wid >> 1, wc = wid & 1, fr = lane & 15, fq = lane >> 4;
  const int hh = (col0 + wc * 64) >> 6;
  char* ws = p.ws;
  const float2* rope = (const float2*)(ws + O_ROPE);
  if (hh == 41) {
    if (fq < 2) {
      float* WI = (float*)(ws + O_WI);
#pragma unroll
      for (int m = 0; m < MR; ++m) {
        const int tok = row0 + wr * (MR * 16) + m * 16 + fr;
        const float sc = 0.04419417382415922f;
        *(f32x4*)(WI + tok * 8 + 4 * fq) = (f32x4){acc[m][0][0] * sc, acc[m][0][1] * sc, acc[m][0][2] * sc, acc[m][0][3] * sc};
      }
    }
    return;
  }
  const int kind = (hh < 10 || (hh >= 23 && hh < 35)) ? 2 : (hh < 12 ? 2 : (hh < 14 ? 0 : (hh < 23 ? 1 : 0)));
  const bool kv = hh >= 10 && hh < 14;
  const float oscale = (hh < 10 || (hh >= 23 && hh < 29)) ? 0.125f : 1.f;
  size_t dbase; int dstride, dcol;
  if (hh < 10) { dbase = O_QA; dstride = 640; dcol = hh * 64; }
  else if (hh < 12) { dbase = O_KV; dstride = 128; dcol = 0; }
  else if (hh < 14) { dbase = O_KV; dstride = 128; dcol = 64; }
  else if (hh < 22) { dbase = O_QI; dstride = 512; dcol = (hh - 14) * 64; }
  else if (hh < 23) { dbase = O_KI; dstride = 64; dcol = 0; }
  else if (hh < 29) { dbase = O_QB; dstride = 384; dcol = (hh - 23) * 64; }
  else if (hh < 35) { dbase = O_KB; dstride = 384; dcol = (hh - 29) * 64; }
  else { dbase = O_VB; dstride = 384; dcol = (hh - 35) * 64; }
  u16* dst = (u16*)(ws + dbase);
  const int kvh = kv ? ((hh < 12) ? hh - 10 : hh - 12) : 0;
  f32x4 gn[4];
#pragma unroll
  for (int n = 0; n < 4; ++n) {
    const f32x4 ga = *(const f32x4*)(p.qna + n * 16 + 4 * fq), gb = *(const f32x4*)(p.kna + n * 16 + 4 * fq);
    const f32x4 gc = *(const f32x4*)(p.qnb + n * 16 + 4 * fq), gd = *(const f32x4*)(p.knb + n * 16 + 4 * fq);
    gn[n] = hh < 10 ? ga : hh < 12 ? gb : hh < 29 ? gc : gd;
  }
  float kss_max = 0.f;
#pragma unroll
  for (int m = 0; m < MR; ++m) {
    const int tok = row0 + wr * (MR * 16) + m * 16 + fr;
    f32x4 v[4];
#pragma unroll
    for (int n = 0; n < 4; ++n) v[n] = acc[m][n];
    if (kind == 2) {
      float ss = 0.f;
#pragma unroll
      for (int n = 0; n < 4; ++n)
#pragma unroll
        for (int j = 0; j < 4; ++j) ss = fmaf(v[n][j], v[n][j], ss);
      ss += __shfl_xor(ss, 16); ss += __shfl_xor(ss, 32);
      const float rstd = rsqrtf(ss * (1.f / 64.f) + EPS_);
#pragma unroll
      for (int n = 0; n < 4; ++n)
#pragma unroll
        for (int j = 0; j < 4; ++j) v[n][j] *= rstd * gn[n][j];
    }
    if (kind >= 1) {
#pragma unroll
      for (int n = 0; n < 2; ++n) {
        const f32x4 ca = *(const f32x4*)(rope + tok * 32 + n * 16 + 4 * fq);
        const f32x4 cb = *(const f32x4*)(rope + tok * 32 + n * 16 + 4 * fq + 2);
        const float cs[4] = {ca[0], ca[2], cb[0], cb[2]}, sn[4] = {ca[1], ca[3], cb[1], cb[3]};
#pragma unroll
        for (int j = 0; j < 4; ++j) {
          const float t1 = v[n][j], t2 = v[n + 2][j];
          v[n][j] = t1 * cs[j] - t2 * sn[j]; v[n + 2][j] = t2 * cs[j] + t1 * sn[j];
        }
      }
    }
    size_t rowoff;
    if (kv) { const int b = tok >> 13, s_ = tok & 8191; rowoff = ((size_t)(b * 2 + kvh) * 8192 + s_) * 128; }
    else rowoff = (size_t)tok * dstride;
    float kss = 0.f;
#pragma unroll
    for (int n = 0; n < 4; ++n) {
      const u32x2 pk = {pack2(v[n][0] * oscale, v[n][1] * oscale), pack2(v[n][2] * oscale, v[n][3] * oscale)};
      *(u32x2*)(dst + rowoff + dcol + n * 16 + 4 * fq) = pk;
      if (hh == 22) {
        const float a0 = __uint_as_float(pk[0] << 16), a1 = __uint_as_float(pk[0] & 0xffff0000u);
        const float a2 = __uint_as_float(pk[1] << 16), a3 = __uint_as_float(pk[1] & 0xffff0000u);
        kss += a0 * a0 + a1 * a1 + a2 * a2 + a3 * a3;
      }
    }
    if (hh == 22) { kss += __shfl_xor(kss, 16); kss += __shfl_xor(kss, 32); kss_max = fmaxf(kss_max, kss); }
  }
  if (hh == 22) {
#pragma unroll
    for (int o = 1; o < 16; o <<= 1) kss_max = fmaxf(kss_max, __shfl_xor(kss_max, o));
    if (lane == 0) atomicMax((u32*)(ws + O_KMAX) + (row0 >> 13), __float_as_uint(kss_max));
  }
}

__device__ __forceinline__ void phase_proj(const Params& p, char* smem, int bid, int nblk) {
  const u16* H = (const u16*)(p.ws + O_H);
  const u16* W = (const u16*)(p.ws + O_WT_IN);
  auto mk = [&](int it) { G2Desc d; d.bperm = 0; d.A = H + (size_t)(it / 21) * 256 * 2048; d.B = W + (size_t)(it % 21) * 128 * 1024; d.lda = 2048; d.ldb = 1024; d.rmax = 255; d.tab = nullptr; return d; };
  int k = 0, it = xcd_item(bid, nblk, 0, 128 * 21);
  if (it < 0) return;
  G2Desc dc = mk(it); G2State st;
  g2_begin(smem, dc, 32, st);
  while (true) {
    const int itn = xcd_item(bid, nblk, ++k, 128 * 21);
    G2Desc dn = dc; if (itn >= 0) dn = mk(itn);
    f32x4 acc[8][4];
    g2_run(smem, dc, 32, itn >= 0, dn, acc, st);
    epi_proj<8>(p, acc, (it / 21) * 256, (it % 21) * 128);
    if (itn < 0) break;
    it = itn; dc = dn;
  }
}

__device__ __forceinline__ void phase_outproj(const Params& p, char* smem, int bid, int nblk) {
  const int tid = fresh_tid(), lane = tid & 63, wid = tid >> 6, wr = wid >> 1, wc = wid & 1, fr = lane & 15, fq = lane >> 4;
  const u16* A = (const u16*)(p.ws + O_O);
  const u16* W = (const u16*)(p.ws + O_WT_OUT);
  const float* mod = (const float*)(p.ws + O_MOD);
  auto mk = [&](int it) { G2Desc d; d.bperm = 0; d.A = A + (size_t)(it >> 3) * 256 * 1024; d.B = W + (size_t)(it & 7) * 128 * 1024; d.lda = 1024; d.ldb = 1024; d.rmax = 255; d.tab = nullptr; return d; };
  int k = 0, it = xcd_item(bid, nblk, 0, 128 * 8);
  if (it < 0) return;
  G2Desc dc = mk(it); G2State st;
  g2_begin(smem, dc, 32, st);
  while (true) {
    const int itn = xcd_item(bid, nblk, ++k, 128 * 8);
    G2Desc dn = dc; if (itn >= 0) dn = mk(itn);
    f32x4 acc[8][4];
    g2_run(smem, dc, 32, itn >= 0, dn, acc, st);
    const int row0 = (it >> 3) * 256, col0 = (it & 7) * 128, b = row0 >> 13;
    const float* xp = p.x + (size_t)(row0 + wr * 128 + fr) * 1024 + col0 + wc * 64 + 4 * fq;
    float* op = p.out + (size_t)(row0 + wr * 128 + fr) * 1024 + col0 + wc * 64 + 4 * fq;
    const float* gp = mod + b * 6144 + 2 * 1024 + col0 + wc * 64 + 4 * fq;
#pragma unroll
    for (int n = 0; n < 4; ++n) {
      const f32x4 gt = *(const f32x4*)(gp + n * 16);
      f32x4 xv[8];
#pragma unroll
      for (int m = 0; m < 8; ++m) xv[m] = *(const f32x4*)(xp + m * 16384 + n * 16);
#pragma unroll
      for (int m = 0; m < 8; ++m) *(f32x4*)(op + m * 16384 + n * 16) = xv[m] + gt * acc[m][n];
    }
    if (itn < 0) break;
    it = itn; dc = dn;
  }
}

__device__ __forceinline__ void phase_router_sgu(const Params& p, char* smem, int bid, int nblk) {
  const int tid = fresh_tid(), lane = tid & 63, wid = tid >> 6, wr = wid >> 1, wc = wid & 1, fr = lane & 15, fq = lane >> 4;
  const u16* H = (const u16*)(p.ws + O_H);
  {
    const u16* W = (const u16*)(p.ws + O_WT_RT);
    float* L = (float*)(p.ws + O_LOGITS);
    int k = 0, it = xcd_item(bid, nblk, 0, 512);
    if (it >= 0) {
      GDesc dc = g_make(H + (size_t)(it >> 1) * 128 * 2048, ARowLin{2048}, W + (size_t)(it & 1) * 128 * 3072, 3072, 1);
      g_begin(smem, dc, 96);
      while (true) {
        const int itn = xcd_item(bid, nblk, ++k, 512);
        GDesc dn = dc;
        if (itn >= 0) dn = g_make(H + (size_t)(itn >> 1) * 128 * 2048, ARowLin{2048}, W + (size_t)(itn & 1) * 128 * 3072, 3072, 1);
        f32x4 acc[4][4];
        g_run(smem, dc, 96, itn >= 0, dn, acc);
        const int row0 = (it >> 1) * 128, col0 = (it & 1) * 128;
#pragma unroll
        for (int m = 0; m < 4; ++m)
#pragma unroll
          for (int n = 0; n < 4; ++n)
            *(f32x4*)(L + (size_t)(row0 + wr * 64 + m * 16 + fr) * 256 + col0 + wc * 64 + n * 16 + 4 * fq) = acc[m][n];
        if (itn < 0) break;
        it = itn; dc = dn;
      }
    }
  }
  {
    const u16* W = (const u16*)(p.ws + O_WT_SGU);
    u16* AS = (u16*)(p.ws + O_ACTS);
    int k = 0, it = xcd_item(bid, nblk, 0, 1024);
    if (it >= 0) {
      GDesc dc = g_make(H + (size_t)(it >> 2) * 128 * 2048, ARowLin{2048}, W + (size_t)(it & 3) * 128 * 1024, 1024, 0);
      g_begin(smem, dc, 32);
      while (true) {
        const int itn = xcd_item(bid, nblk, ++k, 1024);
        GDesc dn = dc;
        if (itn >= 0) dn = g_make(H + (size_t)(itn >> 2) * 128 * 2048, ARowLin{2048}, W + (size_t)(itn & 3) * 128 * 1024, 1024, 0);
        f32x4 acc[4][4];
        g_run(smem, dc, 32, itn >= 0, dn, acc);
        const int row0 = (it >> 2) * 128, col0 = (it & 3) * 128;
        const int acol0 = (col0 + wc * 64) >> 1;
#pragma unroll
        for (int m = 0; m < 4; ++m)
#pragma unroll
          for (int n = 0; n < 2; ++n) {
            const f32x4 g = acc[m][n], u = acc[m][n + 2];
            const u32x2 pk = {pack2(silu_f(g[0]) * u[0], silu_f(g[1]) * u[1]), pack2(silu_f(g[2]) * u[2], silu_f(g[3]) * u[3])};
            *(u32x2*)(AS + (size_t)(row0 + wr * 64 + m * 16 + fr) * 256 + acol0 + n * 16 + 4 * fq) = pk;
          }
        if (itn < 0) break;
        it = itn; dc = dn;
      }
    }
  }
}

DI void route_token(const Params& p, int tok) {
  const int lane = fresh_tid() & 63;
  const float4 lg = *(const float4*)((const float*)(p.ws + O_LOGITS) + (size_t)tok * 256 + lane * 4);
  const float4 bs = *(const float4*)(p.rbias + lane * 4);
  float sc[4] = {sigmoid_f(lg.x), sigmoid_f(lg.y), sigmoid_f(lg.z), sigmoid_f(lg.w)};
  float bi[4] = {sc[0] + bs.x, sc[1] + bs.y, sc[2] + bs.z, sc[3] + bs.w};
  float t1 = fmaxf(bi[0], bi[1]), t2 = fminf(bi[0], bi[1]);
  { float a = fmaxf(bi[2], bi[3]), b = fminf(bi[2], bi[3]);
    float n1 = fmaxf(t1, a), n2 = fmaxf(fminf(t1, a), fmaxf(t2, b)); t1 = n1; t2 = n2; }
#pragma unroll
  for (int o = 1; o < 8; o <<= 1) {
    float a = __shfl_xor(t1, o), b = __shfl_xor(t2, o);
    float n1 = fmaxf(t1, a), n2 = fmaxf(fminf(t1, a), fmaxf(t2, b)); t1 = n1; t2 = n2;
  }
  const float gs = t1 + t2;
  const int g = lane >> 3;
  int rank = 0;
#pragma unroll
  for (int gg = 0; gg < 8; ++gg) { const float o = __shfl(gs, gg * 8); rank += (o > gs || (o == gs && gg < g)) ? 1 : 0; }
  const bool allowed = rank < 4;
  float cand[4];
#pragma unroll
  for (int e = 0; e < 4; ++e) cand[e] = allowed ? bi[e] : -INFINITY;
  int sel[8]; float gsel[8]; float gsum = 0.f;
#pragma unroll
  for (int k = 0; k < 8; ++k) {
    float bv = cand[0]; int be = 0;
#pragma unroll
    for (int e = 1; e < 4; ++e) if (cand[e] > bv) { bv = cand[e]; be = e; }
    int bidx = lane * 4 + be;
#pragma unroll
    for (int o = 1; o < 64; o <<= 1) {
      const float ov = __shfl_xor(bv, o); const int oi = __shfl_xor(bidx, o);
      if (ov > bv || (ov == bv && oi < bidx)) { bv = ov; bidx = oi; }
    }
    sel[k] = bidx;
    const int ol = bidx >> 2, oe = bidx & 3;
    float sv = (oe == 0) ? sc[0] : (oe == 1) ? sc[1] : (oe == 2) ? sc[2] : sc[3];
    sv = __shfl(sv, ol);
    gsel[k] = sv; gsum += sv;
    if (lane == ol) {
#pragma unroll
      for (int e = 0; e < 4; ++e) if (e == oe) cand[e] = -INFINITY;
    }
  }
  if (lane < 8) {
    int e = sel[0]; float gv = gsel[0];
#pragma unroll
    for (int k = 1; k < 8; ++k) if (lane == k) { e = sel[k]; gv = gsel[k]; }
    const int pos = atomicAdd((int*)(p.ws + O_CNT) + e, 1);
    ((int*)(p.ws + O_SELE))[tok * 8 + lane] = e;
    ((float*)(p.ws + O_GATE))[tok * 8 + lane] = gv / gsum * 2.5f;
    ((int*)(p.ws + O_POSE))[tok * 8 + lane] = pos;
  }
}

__device__ __forceinline__ void phase_route_sdown(const Params& p, char* smem, int bid, int nblk) {
  const int tid = fresh_tid(), lane = tid & 63, wid = tid >> 6, wr = wid >> 1, wc = wid & 1, fr = lane & 15, fq = lane >> 4;
  for (int it = bid; it < NTOK / 64; it += nblk)
    for (int i = 0; i < 16; ++i) route_token(p, it * 64 + wid * 16 + i);
  const u16* A = (const u16*)(p.ws + O_ACTS);
  const u16* W = (const u16*)(p.ws + O_WT_SD);
  const float* mod = (const float*)(p.ws + O_MOD);
  int k = 0, it = xcd_item(bid, nblk, 0, 256 * 8);
  if (it < 0) return;
  GDesc dc = g_make(A + (size_t)(it >> 3) * 128 * 256, ARowLin{256}, W + (size_t)(it & 7) * 128 * 256, 256, 0);
  g_begin(smem, dc, 8);
  while (true) {
    const int itn = xcd_item(bid, nblk, ++k, 256 * 8);
    GDesc dn = dc;
    if (itn >= 0) dn = g_make(A + (size_t)(itn >> 3) * 128 * 256, ARowLin{256}, W + (size_t)(itn & 7) * 128 * 256, 256, 0);
    f32x4 acc[4][4];
    g_run(smem, dc, 8, itn >= 0, dn, acc);
    const int row0 = (it >> 3) * 128, col0 = (it & 7) * 128, b = row0 >> 13;
#pragma unroll
    for (int n = 0; n < 4; ++n) {
      const int col = col0 + wc * 64 + n * 16 + 4 * fq;
      const f32x4 gt = *(const f32x4*)(mod + b * 6144 + 5 * 1024 + col);
#pragma unroll
      for (int m = 0; m < 4; ++m) {
        const size_t o = (size_t)(row0 + wr * 64 + m * 16 + fr) * 1024 + col;
        const f32x4 ov = *(const f32x4*)(p.out + o);
        *(f32x4*)(p.out + o) = ov + gt * acc[m][n];
      }
    }
    if (itn < 0) break;
    it = itn; dc = dn;
  }
}

DI void expert_tables(const Params& p, int* off, int* toff, int tshift = 7) {
  const int tid = fresh_tid();
  __syncthreads();
  const int cnt = ((const int*)(p.ws + O_CNT))[tid];
  off[tid + 1] = cnt; toff[tid + 1] = (cnt + (1 << tshift) - 1) >> tshift;
  if (tid == 0) { off[0] = 0; toff[0] = 0; }
  __syncthreads();
  if (tid < 64) {
    int a[4], b[4]; int sa = 0, sb = 0;
#pragma unroll
    for (int i = 0; i < 4; ++i) { sa += off[1 + tid * 4 + i]; a[i] = sa; sb += toff[1 + tid * 4 + i]; b[i] = sb; }
    int pa = sa, pb = sb;
#pragma unroll
    for (int o = 1; o < 64; o <<= 1) { int ta = __shfl_up(pa, o), tb = __shfl_up(pb, o); if (tid >= o) { pa += ta; pb += tb; } }
    pa -= sa; pb -= sb;
#pragma unroll
    for (int i = 0; i < 4; ++i) { off[1 + tid * 4 + i] = pa + a[i]; toff[1 + tid * 4 + i] = pb + b[i]; }
  }
  __syncthreads();
}
DI int find_expert(const int* toff, int tile) {
  int lo = 0, hi = 255;
  while (lo < hi) { int mid = (lo + hi + 1) >> 1; if (toff[mid] <= tile) lo = mid; else hi = mid - 1; }
  return lo;
}

__device__ __forceinline__ void phase_dispatch(const Params& p, char* smem, int bid, int nblk) {
  int* off = (int*)(smem + 73728); int* toff = off + 260;
  expert_tables(p, off, toff);
  const int* sele = (const int*)(p.ws + O_SELE); const int* pose = (const int*)(p.ws + O_POSE);
  const float* gate = (const float*)(p.ws + O_GATE);
  int* tokslot = (int*)(p.ws + O_TOKSLOT); int* slottok = (int*)(p.ws + O_SLOTTOK); float* slotgate = (float*)(p.ws + O_SLOTGATE);
  for (int i = bid * THREADS + fresh_tid(); i < NSLOT; i += nblk * THREADS) {
    const int slot = off[sele[i]] + pose[i];
    tokslot[i] = slot; slottok[slot] = i >> 3; slotgate[slot] = gate[i];
  }
}

struct MoeItem { int e, s0, send, col0; };
DI MoeItem moe_item(const int* off, const int* toff, int it, int nshift) {
  const int tile = it >> nshift, nt = it & ((1 << nshift) - 1), e = find_expert(toff, tile);
  MoeItem m; m.e = e; m.s0 = off[e] + (tile - toff[e]) * 256; m.send = off[e + 1]; m.col0 = nt * 128;
  return m;
}
__device__ __forceinline__ void phase_moe_up(const Params& p, char* smem, int bid, int nblk) {
  const int tid = fresh_tid(), lane = tid & 63, wid = tid >> 6, wr = wid >> 1, wc = wid & 1, fr = lane & 15, fq = lane >> 4;
  int* off = (int*)(smem + 73728); int* toff = off + 260;
  u32* gtab = (u32*)(smem + 73728 + 2560);
  float* gate_t = (float*)(smem + 73728 + 2560 + 2048);
  expert_tables(p, off, toff, 8);
  const int total = toff[256] * 4;
  const u16* H = (const u16*)(p.ws + O_H);
  const int* slottok = (const int*)(p.ws + O_SLOTTOK);
  const float* slotgate = (const float*)(p.ws + O_SLOTGATE);
  u16* ACT = (u16*)(p.ws + O_ACT);
  auto mk = [&](const MoeItem& m, int par) {
    const int sl = m.s0 + tid;
    gtab[par * 256 + tid] = (u32)(sl < m.send ? slottok[sl] : 0) * 2048u;
    gate_t[par * 256 + tid] = sl < m.send ? slotgate[sl] : 0.f;
    G2Desc d; d.bperm = 0; d.A = H; d.B = (const u16*)(p.ws + O_WT_EGU) + (size_t)m.e * 512 * 1024 + (size_t)m.col0 * 1024; d.lda = 0; d.ldb = 1024; d.rmax = 255; d.tab = gtab + par * 256; d.bperm = 2;
    return d;
  };
  int k = 0, it = xcd_item(bid, nblk, 0, total), par = 0;
  if (it < 0) return;
  MoeItem cur = moe_item(off, toff, it, 2);
  G2Desc dc = mk(cur, par); G2State st;
  g2_begin(smem, dc, 32, st);
  while (true) {
    const int itn = xcd_item(bid, nblk, ++k, total);
    MoeItem nxi = cur; G2Desc dn = dc;
    if (itn >= 0) { nxi = moe_item(off, toff, itn, 2); dn = mk(nxi, par ^ 1); }
    float gw[8];
#pragma unroll
    for (int m = 0; m < 8; ++m) gw[m] = gate_t[par * 256 + wr * 128 + m * 16 + fr];
    f32x4 acc[8][4];
    g2_run(smem, dc, 32, itn >= 0, dn, acc, st);
    const int acol0 = (cur.col0 + wc * 64) >> 1;
#pragma unroll
    for (int m = 0; m < 8; ++m) {
      const int slot = cur.s0 + wr * 128 + m * 16 + fr;
      if (slot < cur.send) {
        const f32x4 g0 = acc[m][0], g1 = acc[m][1], u0 = gw[m] * acc[m][2], u1 = gw[m] * acc[m][3];
        const u32x4 pk = {pack2(silu_f(g0[0]) * u0[0], silu_f(g0[1]) * u0[1]), pack2(silu_f(g0[2]) * u0[2], silu_f(g0[3]) * u0[3]),
                          pack2(silu_f(g1[0]) * u1[0], silu_f(g1[1]) * u1[1]), pack2(silu_f(g1[2]) * u1[2], silu_f(g1[3]) * u1[3])};
        *(u32x4*)(ACT + (size_t)slot * 256 + acol0 + 8 * fq) = pk;
      }
    }
    if (itn < 0) break;
    cur = nxi; dc = dn; par ^= 1;
  }
}

__device__ __forceinline__ void phase_moe_down(const Params& p, char* smem, int bid, int nblk) {
  const int tid = fresh_tid(), lane = tid & 63, wid = tid >> 6, wr = wid >> 1, wc = wid & 1, fr = lane & 15, fq = lane >> 4;
  int* off = (int*)(smem + 73728); int* toff = off + 260;
  expert_tables(p, off, toff, 8);
  const int total = toff[256] * 8;
  const u16* ACT = (const u16*)(p.ws + O_ACT);
  u16* Y = (u16*)(p.ws + O_BIG);
  auto mk = [&](const MoeItem& m) {
    G2Desc d; d.bperm = 0; d.A = ACT + (size_t)m.s0 * 256; d.B = (const u16*)(p.ws + O_WT_ED) + (size_t)m.e * 1024 * 256 + (size_t)m.col0 * 256;
    d.lda = 256; d.ldb = 256; d.rmax = min(255, NSLOT - 1 - m.s0); d.tab = nullptr; d.bperm = 1;
    return d;
  };
  int k = 0, it = xcd_item(bid, nblk, 0, total);
  if (it < 0) return;
  MoeItem cur = moe_item(off, toff, it, 3);
  G2Desc dc = mk(cur); G2State st;
  g2_begin(smem, dc, 8, st);
  while (true) {
    const int itn = xcd_item(bid, nblk, ++k, total);
    MoeItem nxi = cur; G2Desc dn = dc;
    if (itn >= 0) { nxi = moe_item(off, toff, itn, 3); dn = mk(nxi); }
    f32x4 acc[8][4];
    g2_run(smem, dc, 8, itn >= 0, dn, acc, st);
#pragma unroll
    for (int m = 0; m < 8; ++m) {
      const int slot = cur.s0 + wr * 128 + m * 16 + fr;
      if (slot < cur.send) {
#pragma unroll
        for (int h = 0; h < 2; ++h) {
          const f32x4 a = acc[m][2 * h], c = acc[m][2 * h + 1];
          const u32x4 pk = {pack2(a[0], a[1]), pack2(a[2], a[3]), pack2(c[0], c[1]), pack2(c[2], c[3])};
          *(u32x4*)(Y + (size_t)slot * 1024 + cur.col0 + wc * 64 + 16 * fq + 8 * h) = pk;
        }
      }
    }
    if (itn < 0) break;
    cur = nxi; dc = dn;
  }
}

__device__ __forceinline__ void phase_combine(const Params& p, int bid, int nblk) {
  const int lane = fresh_tid() & 63, wid = fresh_tid() >> 6;
  const u16* Y = (const u16*)(p.ws + O_BIG);
  const int* tokslot = (const int*)(p.ws + O_TOKSLOT);
  const float* mod = (const float*)(p.ws + O_MOD);
  for (int it = bid; it < NTOK / 4; it += nblk) {
    const int tok = it * 4 + wid, b = tok >> 13;
    int sl[8];
#pragma unroll
    for (int k = 0; k < 8; ++k) sl[k] = tokslot[tok * 8 + k];
#pragma unroll
    for (int h = 0; h < 2; ++h) {
      const int col = h * 512 + lane * 8;
      float a[8] = {0.f, 0.f, 0.f, 0.f, 0.f, 0.f, 0.f, 0.f};
#pragma unroll
      for (int k = 0; k < 8; ++k) {
        const u32x4 v = *(const u32x4*)(Y + (size_t)sl[k] * 1024 + col);
#pragma unroll
        for (int e = 0; e < 4; ++e) { a[2 * e] += __uint_as_float(v[e] << 16); a[2 * e + 1] += __uint_as_float(v[e] & 0xffff0000u); }
      }
      float* o = p.out + (size_t)tok * 1024 + col;
      const float* g = mod + b * 6144 + 5 * 1024 + col;
      float4 o0 = *(float4*)o, o1 = *(float4*)(o + 4);
      const float4 g0 = *(const float4*)g, g1 = *(const float4*)(g + 4);
      o0.x += g0.x * a[0]; o0.y += g0.y * a[1]; o0.z += g0.z * a[2]; o0.w += g0.w * a[3];
      o1.x += g1.x * a[4]; o1.y += g1.y * a[5]; o1.z += g1.z * a[6]; o1.w += g1.w * a[7];
      *(float4*)o = o0; *(float4*)(o + 4) = o1;
    }
  }
}

constexpr int IDX_NB = 256, IDX_CB = 128;
constexpr int IX_A = 32768;
constexpr int IX_W = 65536, IX_SCALE = IX_W + 1024, IX_OFF = IX_SCALE + 128, IX_THR = IX_OFF + 128, IX_ABOVE = IX_THR + 128,
              IX_CIN = IX_ABOVE + 128, IX_LCS = IX_CIN + 128, IX_UCS = IX_LCS + 128, IX_FLAG = IX_UCS + 128, IX_DUMMY = IX_FLAG + 16,
              IX_LIST = IX_DUMMY + 16, IX_LIST_STRIDE = 256 + 1024, IX_END = IX_LIST + 4 * IX_LIST_STRIDE;
static_assert(IX_END <= SMEM_BYTES, "indexer LDS");
constexpr size_t O_BINS = O_O;
constexpr size_t BINS_PER_BATCH = (size_t)1024 * (256 * 257 / 2);
static_assert(O_BINS + 4 * BINS_PER_BATCH <= O_ACT, "bin image does not fit");

DI u32 mono_f32(float f) { const u32 u = __float_as_uint(f); return (u >> 31) ? ~u : (u | 0x80000000u); }

__device__ __forceinline__ void indexer_item(const Params& p, char* smem, int b, int qb) {
  const int tid = fresh_tid(), lane = tid & 63, wid = tid >> 6, hl = lane >> 5;
  const int q0 = qb * 32, tok0 = b * S_ + q0, KW = (qb + 1) * 32;
  const u16* QI = (const u16*)(p.ws + O_QI);
  const u16* KI = (const u16*)(p.ws + O_KI) + (size_t)b * S_ * 64;
  const float* WI = (const float*)(p.ws + O_WI);
  u16* SEL = (u16*)(p.ws + O_SEL);
  int* SELCNT = (int*)(p.ws + O_SELCNT);
  unsigned char* BINS = (unsigned char*)(p.ws + O_BINS) + (size_t)b * BINS_PER_BATCH + (size_t)1024 * (qb * (qb + 1) / 2);
  float* w_lds = (float*)(smem + IX_W);
  float* sc_lds = (float*)(smem + IX_SCALE); float* of_lds = (float*)(smem + IX_OFF);
  float* lcs_lds = (float*)(smem + IX_LCS); float* ucs_lds = (float*)(smem + IX_UCS);
  int* thr_lds = (int*)(smem + IX_THR); int* above_lds = (int*)(smem + IX_ABOVE); int* cin_lds = (int*)(smem + IX_CIN);
  int* flag_lds = (int*)(smem + IX_FLAG);
  u32* hist = (u32*)smem;
  __syncthreads();
  {
    const int q = tid >> 3, h = tid & 7;
    const u16* qr = QI + (size_t)(tok0 + q) * 512 + h * 64;
    float ss = 0.f;
#pragma unroll
    for (int i = 0; i < 8; ++i) { const u32x4 v = *(const u32x4*)(qr + i * 8);
      *(u32x4*)(smem + IX_A + tid * 128 + ((i ^ ((tid >> 1) & 7)) * 16)) = v;
#pragma unroll
      for (int e = 0; e < 4; ++e) { float a = __uint_as_float(v[e] << 16), c = __uint_as_float(v[e] & 0xffff0000u); ss += a * a + c * c; } }
    const float kmax = sqrtf(__uint_as_float(((const u32*)(p.ws + O_KMAX))[b]));
    const float nrm = sqrtf(ss) * kmax, w = WI[(tok0 + q) * 8 + h];
    w_lds[q * 8 + h] = 0.5f * w;
    float ps = w > 0.f ? w * nrm : 0.f, ns = w < 0.f ? -w * nrm : 0.f;
    float mu = w * nrm * (0.3989423f * 0.125f), var = w * w * nrm * nrm * (0.3408f / 64.f);
#pragma unroll
    for (int o = 1; o < 8; o <<= 1) { ps += __shfl_xor(ps, o); ns += __shfl_xor(ns, o); mu += __shfl_xor(mu, o); var += __shfl_xor(var, o); }
    float U = ps, L = -ns; const float span = U - L;
    U += span * 1e-3f + 1e-30f; L -= span * 1e-3f + 1e-30f;
    const float sd = sqrtf(var);
    const float pq = fminf(256.f / (float)(q0 + q + 1), 0.999f), pt = pq > 0.5f ? 1.f - pq : pq;
    const float tt_ = sqrtf(-2.f * __logf(pt));
    float zq = tt_ - (2.515517f + 0.802853f * tt_ + 0.010328f * tt_ * tt_) / (1.f + 1.432788f * tt_ + 0.189269f * tt_ * tt_ + 0.001308f * tt_ * tt_ * tt_);
    zq = pq > 0.5f ? -zq : zq;
    const float lo = fmaxf(L, mu + (zq - 3.5f) * sd), hi = fminf(U, mu + (zq + 3.5f) * sd);
    const float scale = (float)(IDX_NB - 2) / fmaxf(hi - lo, 1e-30f);
    if (h == 0) { sc_lds[q] = scale; of_lds[q] = 1.f - lo * scale; lcs_lds[q] = L; ucs_lds[q] = U;
                  thr_lds[q] = -1; above_lds[q] = 0; cin_lds[q] = 0; }
    if (tid == 0) flag_lds[0] = 0;
  }
  for (int i = tid; i < 32768 / 16; i += THREADS) ((u32x4*)smem)[i] = (u32x4){0u, 0u, 0u, 0u};
  int aoff[4];
  { const int r = lane & 31, tq = 2 * ((r >> 2) & 1) + (r >> 4), h = (r & 3) + 4 * ((r >> 3) & 1), rowg = tq * 8 + h;
#pragma unroll
    for (int ks = 0; ks < 4; ++ks) aoff[ks] = IX_A + rowg * 128 + (((2 * ks + hl) ^ ((rowg >> 1) & 7)) * 16); }
  __syncthreads();
  const int nchunk = (qb + 4) >> 2;
  int iter = 0;
  bool again = (q0 + 32) > NSEL;
  while (again) {
    for (int ch = wid; ch < nchunk; ch += 4) {
      bf16x8 Bf[4][4];
#pragma unroll
      for (int tt = 0; tt < 4; ++tt) {
        const int keyl = min((ch * 4 + tt) * 32 + (lane & 31), S_ - 1);
#pragma unroll
        for (int ks = 0; ks < 4; ++ks) Bf[tt][ks] = *(const bf16x8*)(KI + (size_t)keyl * 64 + ks * 16 + 8 * hl);
      }
#pragma unroll 1
      for (int rt = 0; rt < 8; ++rt) {
        bf16x8 Af[4];
#pragma unroll
        for (int ks = 0; ks < 4; ++ks) Af[ks] = *(const bf16x8*)(smem + aoff[ks] + rt * 4096);
        const int qa = rt * 4 + 2 * hl;
        const f32x4 wa0 = *(const f32x4*)(w_lds + qa * 8), wa1 = *(const f32x4*)(w_lds + qa * 8 + 4);
        const f32x4 wb0 = *(const f32x4*)(w_lds + qa * 8 + 8), wb1 = *(const f32x4*)(w_lds + qa * 8 + 12);
        const float sca = sc_lds[qa], scb = sc_lds[qa + 1], ofa = of_lds[qa], ofb = of_lds[qa + 1];
#pragma unroll
        for (int tp = 0; tp < 2; ++tp) {
          f32x16 acc[2];
#pragma unroll
          for (int t2 = 0; t2 < 2; ++t2) {
#pragma unroll
            for (int i = 0; i < 16; ++i) acc[t2][i] = 0.f;
#pragma unroll
            for (int ks = 0; ks < 4; ++ks) acc[t2] = MFMA32(Af[ks], Bf[tp * 2 + t2][ks], acc[t2]);
          }
#pragma unroll
          for (int t2 = 0; t2 < 2; ++t2) {
            const int kt = ch * 4 + tp * 2 + t2;
            if (kt <= qb) {
              const int key = kt * 32 + (lane & 31);
#pragma unroll
              for (int u = 0; u < 2; ++u) {
                const int q = qa + u;
                const f32x4 w0 = u ? wb0 : wa0, w1 = u ? wb1 : wa1;
                float s1 = 0.f, s2 = 0.f;
#pragma unroll
                for (int h = 0; h < 4; ++h) { const float x = acc[t2][8 * u + h]; s1 = fmaf(w0[h], x, s1); s2 = fmaf(w0[h], __builtin_fabsf(x), s2); }
#pragma unroll
                for (int h = 0; h < 4; ++h) { const float x = acc[t2][8 * u + 4 + h]; s1 = fmaf(w1[h], x, s1); s2 = fmaf(w1[h], __builtin_fabsf(x), s2); }
                const float s = s1 + s2;
                int bin = (int)fmaf(s, u ? scb : sca, u ? ofb : ofa);
                bin = min(max(bin, 0), IDX_NB - 1);
                const bool valid = key <= q0 + q;
                atomicAdd((u32*)(smem + (valid ? (q * IDX_NB + bin) * 4 : IX_DUMMY)), 1u);
                BINS[(u32)(q * KW + key)] = (unsigned char)bin;
              }
            }
          }
        }
      }
    }
    __syncthreads();
    for (int qq = 0; qq < 8; ++qq) {
      const int q = wid * 8 + qq;
      const u32x4 wv = *(const u32x4*)(hist + q * IDX_NB + lane * 4);
      const int local = (int)(wv[0] + wv[1] + wv[2] + wv[3]);
      int suf = local;
#pragma unroll
      for (int o = 1; o < 64; o <<= 1) { const int t = __shfl_down(suf, o); if (lane + o < 64) suf += t; }
      if (suf >= NSEL && suf - local < NSEL) {
        int cum = suf - local, bt = 0, ab = 0, cin = 0; bool found = false;
#pragma unroll
        for (int i = 3; i >= 0; --i) {
          const int c = (int)wv[i];
          if (!found) { if (cum + c >= NSEL) { found = true; bt = lane * 4 + i; ab = cum; cin = c; } else cum += c; }
        }
        thr_lds[q] = bt; above_lds[q] = ab; cin_lds[q] = cin;
        if (cin > IDX_CB) flag_lds[0] = 1;
      }
    }
    __syncthreads();
    again = flag_lds[0] != 0 && iter < 3;
    __syncthreads();
    if (again) {
      if (tid < 32 && cin_lds[tid] > IDX_CB) {
        const int q = tid, bt = thr_lds[q];
        const float sc = sc_lds[q], of = of_lds[q], inv = 1.f / sc;
        float lo = ((float)bt - of) * inv, hi = ((float)(bt + 1) - of) * inv;
        if (bt == 0) lo = lcs_lds[q];
        if (bt == IDX_NB - 1) hi = ucs_lds[q];
        const float wdt = hi - lo; lo -= 0.02f * wdt; hi += 0.02f * wdt;
        const float nsc = (float)(IDX_NB - 2) / (hi - lo);
        if (nsc < 1e30f && nsc > sc) { sc_lds[q] = nsc; of_lds[q] = 1.f - lo * nsc; }
      }
      if (tid == 0) flag_lds[0] = 0;
      ++iter;
      for (int i = tid; i < 32768 / 16; i += THREADS) ((u32x4*)smem)[i] = (u32x4){0u, 0u, 0u, 0u};
      __syncthreads();
    }
  }
  asm volatile("s_waitcnt vmcnt(0)" ::: "memory");
  __syncthreads();
  u16* ambk = (u16*)(smem + IX_LIST + wid * IX_LIST_STRIDE);
  u64* comp = (u64*)(smem + IX_LIST + wid * IX_LIST_STRIDE + 256);
  const unsigned long long lt_mask = (1ull << lane) - 1ull;
  for (int qq = 0; qq < 8; ++qq) {
    const int q = wid * 8 + qq, tok = tok0 + q, n = q0 + q + 1;
    u16* selrow = SEL + (size_t)tok * NSEL;
    int total;
    if (n <= NSEL) {
      for (int i = lane; i < n; i += 64) selrow[i] = (u16)i;
      total = n;
    } else {
      const int tc = thr_lds[q];
      const unsigned char* row = BINS + (size_t)q * KW;
      int base = 0, na = 0;
      u32 w4[4];
#pragma unroll
      for (int u = 0; u < 4; ++u) w4[u] = __builtin_nontemporal_load((const u32*)(row + (u32)(lane * 4)) + u * 64);
#pragma unroll 1
      for (int k0 = 0; k0 < n; k0 += 1024) {
        u32 wn[4] = {0u, 0u, 0u, 0u};
        if (k0 + 1024 < n) {
#pragma unroll
          for (int u = 0; u < 4; ++u) wn[u] = __builtin_nontemporal_load((const u32*)(row + (u32)(k0 + 1024 + lane * 4)) + u * 64);
        }
#pragma unroll
        for (int u = 0; u < 4; ++u) {
          const int kk = k0 + u * 256 + lane * 4;
#pragma unroll
          for (int j = 0; j < 4; ++j) {
            const int key = kk + j, cb = (int)((w4[u] >> (8 * j)) & 255u);
            const bool valid = key < n, ab = valid && cb > tc, am = valid && cb == tc;
            const unsigned long long mA = __ballot(ab), mB = __ballot(am);
            if (ab) { const int pos = base + __popcll(mA & lt_mask); if (pos < NSEL) selrow[pos] = (u16)key; }
            if (am) { const int pos = na + __popcll(mB & lt_mask); if (pos < IDX_CB) ambk[pos] = (u16)key; }
            base += __popcll(mA); na += __popcll(mB);
          }
        }
#pragma unroll
        for (int u = 0; u < 4; ++u) w4[u] = wn[u];
      }
      base = min(base, NSEL); na = min(na, IDX_CB);
      const int r = NSEL - base;
#pragma unroll 1
      for (int half = 0; half < 2; ++half) {
        const int e = lane + 64 * half;
        if (e < na) {
          const int key = ambk[e];
          const u16* kr = KI + (size_t)key * 64;
          float d[8] = {0.f, 0.f, 0.f, 0.f, 0.f, 0.f, 0.f, 0.f};
          u32x4 kvr[8];
#pragma unroll
          for (int pc = 0; pc < 8; ++pc) kvr[pc] = *(const u32x4*)(kr + pc * 8);
#pragma unroll
          for (int pc = 0; pc < 8; ++pc) {
            const u32x4 kv = kvr[pc];
#pragma unroll
            for (int h = 0; h < 8; ++h) {
              const int rowg = q * 8 + h;
              const u32x4 qv = *(const u32x4*)(smem + IX_A + rowg * 128 + ((pc ^ ((rowg >> 1) & 7)) * 16));
#pragma unroll
              for (int c = 0; c < 4; ++c) {
                d[h] = fmaf(__uint_as_float(qv[c] << 16), __uint_as_float(kv[c] << 16), d[h]);
                d[h] = fmaf(__uint_as_float(qv[c] & 0xffff0000u), __uint_as_float(kv[c] & 0xffff0000u), d[h]);
              }
            }
          }
          float sc = 0.f;
#pragma unroll
          for (int h = 0; h < 8; ++h) sc = fmaf(w_lds[q * 8 + h], d[h] + __builtin_fabsf(d[h]), sc);
          comp[e] = ((u64)mono_f32(sc) << 16) | (u64)(0xFFFF - key);
        }
      }
#pragma unroll 1
      for (int half = 0; half < 2; ++half) {
        const int e = lane + 64 * half;
        const u64 my = e < na ? comp[e] : 0ull;
        int rank = 0;
#pragma unroll 8
        for (int j = 0; j < na; ++j) rank += (comp[j] > my) ? 1 : 0;
        if (e < na && rank < r) selrow[base + rank] = (u16)(0xFFFF - (int)(my & 0xFFFF));
      }
      total = base + min(r, na);
    }
    if (lane == 0) SELCNT[tok] = total;
  }
}

__device__ __forceinline__ void phase_indexer(const Params& p, char* smem, int bid, int nblk) {
  for (int it = bid; it < 1024; it += nblk) {
    const int b = it & 3, j = (it & 511) >> 2, qb = it < 512 ? j : 255 - j;
    indexer_item(p, smem, b, qb);
  }
}

__device__ __forceinline__ void dilated_item(const Params& p, char* smem, int item) {
  const int tid = fresh_tid(), lane = tid & 63, wid = tid >> 6, hl = lane >> 5, ql = lane & 31, i16 = lane & 15;
  const int br = item / 1536, rem = item % 1536, b = rem / 384, h = (rem % 384) >> 6, blk = rem & 63;
  const int lg = 2 * br, dil = 1 << lg, nper = 64 >> lg, r = blk / nper, n = blk % nper;
  const u16* QB = (const u16*)(p.ws + O_QB) + (size_t)b * S_ * 384 + h * 64;
  const u16* KB = (const u16*)(p.ws + O_KB) + (size_t)b * S_ * 384 + h * 64;
  const u16* VB = (const u16*)(p.ws + O_VB) + (size_t)b * S_ * 384 + h * 64;
  __syncthreads();
#pragma unroll
  for (int jj = 0; jj < 8; ++jj) {
    const int piece = tid + 256 * jj, row = piece >> 3, c = piece & 7, mk = 128 * (n - 1) + row;
    u32x4 v = (u32x4){0u, 0u, 0u, 0u};
    if (mk >= 0) v = *(const u32x4*)(VB + (size_t)(mk * dil + r) * 384 + c * 8);
    *(u32x4*)(smem + row * 128 + ((c ^ (((row >> 1) & 1) << 2)) * 16)) = v;
  }
  __syncthreads();
  const int mq0 = 128 * n + 32 * wid;
  bf16x8 Qf[4];
#pragma unroll
  for (int ks = 0; ks < 4; ++ks) Qf[ks] = *(const bf16x8*)(QB + (size_t)((mq0 + ql) * dil + r) * 384 + ks * 16 + 8 * hl);
  f32x16 S[5];
#pragma unroll
  for (int i = 0; i < 5; ++i) {
    const int mk = max(mq0 - 128 + 32 * i + ql, 0);
    const u16* kr = KB + (size_t)(mk * dil + r) * 384 + 8 * hl;
#pragma unroll
    for (int e = 0; e < 16; ++e) S[i][e] = 0.f;
#pragma unroll
    for (int ks = 0; ks < 4; ++ks) S[i] = MFMA32(*(const bf16x8*)(kr + ks * 16), Qf[ks], S[i]);
  }
  float mx = -1e30f;
#pragma unroll
  for (int i = 0; i < 5; ++i)
#pragma unroll
    for (int e = 0; e < 16; ++e) {
      const int cr = (e & 3) + 8 * (e >> 2) + 4 * hl;
      const int key = mq0 - 128 + 32 * i + cr, mq = mq0 + ql;
      const bool valid = key >= 0 && key <= mq && key >= mq - 128;
      S[i][e] = valid ? S[i][e] : -1e30f;
      mx = fmaxf(mx, S[i][e]);
    }
  mx = fmaxf(mx, __shfl_xor(mx, 32));
  float ls = 0.f;
#pragma unroll
  for (int i = 0; i < 5; ++i)
#pragma unroll
    for (int e = 0; e < 16; ++e) { const float pv = __expf(S[i][e] - mx); S[i][e] = pv; ls += pv; }
  ls += __shfl_xor(ls, 32);
  f32x16 O[2];
#pragma unroll
  for (int dt = 0; dt < 2; ++dt)
#pragma unroll
    for (int e = 0; e < 16; ++e) O[dt][e] = 0.f;
#pragma unroll
  for (int i = 0; i < 5; ++i)
#pragma unroll
    for (int s = 0; s < 2; ++s) {
      const bf16x8 Pf = pack8(S[i][8 * s], S[i][8 * s + 1], S[i][8 * s + 2], S[i][8 * s + 3], S[i][8 * s + 4], S[i][8 * s + 5], S[i][8 * s + 6], S[i][8 * s + 7]);
#pragma unroll
      for (int dt = 0; dt < 2; ++dt) {
        const int row1 = 32 * wid + 32 * i + 16 * s + 4 * hl + (i16 >> 2), row2 = row1 + 8;
        const int c = 4 * dt + 2 * ((lane >> 4) & 1) + ((i16 & 3) >> 1), by = 8 * (i16 & 1);
        const s16x4 lo = tr_read(smem + row1 * 128 + ((c ^ (((row1 >> 1) & 1) << 2)) * 16) + by);
        const s16x4 hi = tr_read(smem + row2 * 128 + ((c ^ (((row2 >> 1) & 1) << 2)) * 16) + by);
        const bf16x8 Vf = __builtin_shufflevector(lo, hi, 0, 1, 2, 3, 4, 5, 6, 7);
        O[dt] = MFMA32(Pf, Vf, O[dt]);
      }
    }
  u16* DN = (u16*)(p.ws + O_DNUM) + ((size_t)br * NTOK + (size_t)b * S_) * 384 + h * 64;
  float* DM = (float*)(p.ws + O_DML) + ((size_t)br * NTOK + (size_t)b * S_) * 12 + h * 2;
#pragma unroll
  for (int dt = 0; dt < 2; ++dt)
#pragma unroll
    for (int e = 0; e < 16; ++e) {
      const int cr = (e & 3) + 8 * (e >> 2) + 4 * hl, s = (mq0 + cr) * dil + r;
      DN[(size_t)s * 384 + dt * 32 + ql] = f2bf(O[dt][e]);
    }
  if (hl == 0) { const int s = (mq0 + ql) * dil + r; DM[(size_t)s * 12] = mx; DM[(size_t)s * 12 + 1] = ls; }
}
__device__ __forceinline__ void phase_dilated(const Params& p, char* smem, int bid, int nblk) {
  for (int it = bid; it < 4608; it += nblk) dilated_item(p, smem, it);
}
__device__ __forceinline__ void phase_dil_combine(const Params& p, int bid, int nblk) {
  const u16* DN = (const u16*)(p.ws + O_DNUM); const float* DM = (const float*)(p.ws + O_DML);
  u16* O = (u16*)(p.ws + O_O);
  for (int i = bid * THREADS + fresh_tid(); i < NTOK * 6 * 8; i += nblk * THREADS) {
    const int tok = i / 48, rem = i % 48, h = rem >> 3, d0 = (rem & 7) * 8;
    float m[3], l[3];
#pragma unroll
    for (int br = 0; br < 3; ++br) { m[br] = DM[((size_t)br * NTOK + tok) * 12 + h * 2]; l[br] = DM[((size_t)br * NTOK + tok) * 12 + h * 2 + 1]; }
    const float mm = fmaxf(m[0], fmaxf(m[1], m[2]));
    float w[3], den = 0.f;
#pragma unroll
    for (int br = 0; br < 3; ++br) { w[br] = __expf(m[br] - mm); den += w[br] * l[br]; }
    const float inv = 1.f / den;
    float a[8] = {0.f, 0.f, 0.f, 0.f, 0.f, 0.f, 0.f, 0.f};
#pragma unroll
    for (int br = 0; br < 3; ++br) {
      const u32x4 v = *(const u32x4*)(DN + ((size_t)br * NTOK + tok) * 384 + h * 64 + d0);
#pragma unroll
      for (int e = 0; e < 4; ++e) { a[2 * e] += w[br] * __uint_as_float(v[e] << 16); a[2 * e + 1] += w[br] * __uint_as_float(v[e] & 0xffff0000u); }
    }
    u32x4 o = {pack2(a[0] * inv, a[1] * inv), pack2(a[2] * inv, a[3] * inv), pack2(a[4] * inv, a[5] * inv), pack2(a[6] * inv, a[7] * inv)};
    *(u32x4*)(O + (size_t)tok * 1024 + 640 + h * 64 + d0) = o;
  }
}

__device__ __forceinline__ void sparse_item(const Params& p, char* wbase, int b, int kvh, int q, int (&kraw)[16], int& cnt_io, bool has_next, int qn) {
  const int lane = fresh_tid() & 63, g = lane & 15, G = lane >> 4, i16 = g;
  const int tok = b * S_ + q;
  const u16* QA = (const u16*)(p.ws + O_QA) + (size_t)tok * 640 + kvh * 320;
  const u16* KV = (const u16*)(p.ws + O_KV) + (size_t)(b * 2 + kvh) * S_ * 128;
  const int cnt = cnt_io;
  bf16x8 Qf[2];
#pragma unroll
  for (int ks = 0; ks < 2; ++ks) {
    Qf[ks] = (bf16x8){0, 0, 0, 0, 0, 0, 0, 0};
    if (g < 5) Qf[ks] = *(const bf16x8*)(QA + g * 64 + ks * 32 + 8 * G);
  }
  int keys[16];
#pragma unroll
  for (int i = 0; i < 16; ++i) keys[i] = (16 * i + g) < cnt ? kraw[i] : 0;
  u32x4 vpre[8];
  auto vload = [&](int ci) {
#pragma unroll
    for (int ii = 0; ii < 8; ++ii) {
      const int key = __shfl(keys[4 * ci + (ii >> 1)], 8 * (ii & 1) + (lane >> 3));
      vpre[ii] = *(const u32x4*)(KV + (size_t)key * 128 + 64 + (lane & 7) * 8);
    }
  };
  vload(0);
  f32x4 S[16];
#pragma unroll
  for (int bb = 0; bb < 2; ++bb) {
    bf16x8 ka[8], kb[8];
#pragma unroll
    for (int i = 0; i < 8; ++i) {
      const u16* kr = KV + (size_t)keys[8 * bb + i] * 128 + 8 * G;
      ka[i] = *(const bf16x8*)kr; kb[i] = *(const bf16x8*)(kr + 32);
    }
#pragma unroll
    for (int i = 0; i < 8; ++i) {
      S[8 * bb + i] = (f32x4){0.f, 0.f, 0.f, 0.f};
      S[8 * bb + i] = MFMA16(ka[i], Qf[0], S[8 * bb + i]);
      S[8 * bb + i] = MFMA16(kb[i], Qf[1], S[8 * bb + i]);
    }
    __builtin_amdgcn_sched_barrier(0);
  }
  if (has_next) {
    const u16* seln = (const u16*)(p.ws + O_SEL) + (size_t)(b * S_ + qn) * NSEL;
#pragma unroll
    for (int i = 0; i < 16; ++i) kraw[i] = (int)seln[16 * i + g];
    cnt_io = ((const int*)(p.ws + O_SELCNT))[b * S_ + qn];
  }
  float mx = -1e30f;
#pragma unroll
  for (int i = 0; i < 16; ++i)
#pragma unroll
    for (int e = 0; e < 4; ++e) { const bool valid = (16 * i + 4 * G + e) < cnt; S[i][e] = valid ? S[i][e] : -1e30f; mx = fmaxf(mx, S[i][e]); }
  mx = fmaxf(mx, __shfl_xor(mx, 16)); mx = fmaxf(mx, __shfl_xor(mx, 32));
  float ls = 0.f;
#pragma unroll
  for (int i = 0; i < 16; ++i)
#pragma unroll
    for (int e = 0; e < 4; ++e) { const float pv = __expf(S[i][e] - mx); S[i][e] = pv; ls += pv; }
  ls += __shfl_xor(ls, 16); ls += __shfl_xor(ls, 32);
  f32x4 O[4];
#pragma unroll
  for (int nt = 0; nt < 4; ++nt) O[nt] = (f32x4){0.f, 0.f, 0.f, 0.f};
#pragma unroll
  for (int ci = 0; ci < 4; ++ci) {
#pragma unroll
    for (int ii = 0; ii < 8; ++ii) {
      const int row = 8 * ii + (lane >> 3), c = lane & 7;
      *(u32x4*)(wbase + row * 128 + ((c ^ (((row >> 1) & 3) << 1)) * 16)) = vpre[ii];
    }
    if (ci < 3) vload(ci + 1);
#pragma unroll
    for (int i2 = 0; i2 < 2; ++i2) {
      const int t0 = 4 * ci + 2 * i2;
      const bf16x8 Pf = pack8(S[t0][0], S[t0][1], S[t0][2], S[t0][3], S[t0 + 1][0], S[t0 + 1][1], S[t0 + 1][2], S[t0 + 1][3]);
#pragma unroll
      for (int nt = 0; nt < 4; ++nt) {
        const int row1 = 32 * i2 + 4 * G + (i16 >> 2), row2 = row1 + 16;
        const int c = 2 * nt + ((i16 & 3) >> 1), by = 8 * (i16 & 1);
        const s16x4 lo = tr_read(wbase + row1 * 128 + ((c ^ (((row1 >> 1) & 3) << 1)) * 16) + by);
        const s16x4 hi = tr_read(wbase + row2 * 128 + ((c ^ (((row2 >> 1) & 3) << 1)) * 16) + by);
        const bf16x8 Vf = __builtin_shufflevector(lo, hi, 0, 1, 2, 3, 4, 5, 6, 7);
        O[nt] = MFMA16(Pf, Vf, O[nt]);
      }
    }
  }
  u16* Oo = (u16*)(p.ws + O_O) + (size_t)tok * 1024 + kvh * 320;
#pragma unroll
  for (int e = 0; e < 4; ++e) {
    const int gh = 4 * G + e;
    const float lv = __shfl(ls, gh & 15);
    if (gh < 5) {
      const float inv = 1.f / lv;
#pragma unroll
      for (int nt = 0; nt < 4; ++nt) Oo[gh * 64 + nt * 16 + g] = f2bf(O[nt][e] * inv);
    }
  }
}
__device__ __forceinline__ void phase_sparse(const Params& p, char* smem, int bid, int nblk) {
  const int tid = fresh_tid(), wid = tid >> 6, g = tid & 15;
  char* wbase = smem + wid * 8192;
  const bool aff = (nblk & 7) == 0;
  const int grp = bid & 7, j = bid >> 3, nj = nblk >> 3;
  int it = aff ? j * 4 + wid : bid * 4 + wid;
  const int step = aff ? nj * 4 : nblk * 4, lim = aff ? S_ : NTOK * 2;
  auto dec = [&](int i, int& b, int& kvh, int& q) { if (aff) { b = grp >> 1; kvh = grp & 1; q = i; } else { b = i >> 14; kvh = (i >> 13) & 1; q = i & 8191; } };
  if (it >= lim) return;
  int b, kvh, q; dec(it, b, kvh, q);
  int kraw[16];
  { const u16* sel = (const u16*)(p.ws + O_SEL) + (size_t)(b * S_ + q) * NSEL;
#pragma unroll
    for (int i = 0; i < 16; ++i) kraw[i] = (int)sel[16 * i + g]; }
  int cnt = ((const int*)(p.ws + O_SELCNT))[b * S_ + q];
  while (true) {
    const int itn = it + step; const bool hn = itn < lim;
    int bn = b, kvhn = kvh, qn = q; if (hn) dec(itn, bn, kvhn, qn);
    sparse_item(p, wbase, b, kvh, q, kraw, cnt, hn && bn == b, qn);
    if (!hn) break;
    if (bn != b) {
      const u16* sel = (const u16*)(p.ws + O_SEL) + (size_t)(bn * S_ + qn) * NSEL;
#pragma unroll
      for (int i = 0; i < 16; ++i) kraw[i] = (int)sel[16 * i + g];
      cnt = ((const int*)(p.ws + O_SELCNT))[bn * S_ + qn];
    }
    it = itn; b = bn; kvh = kvhn; q = qn;
  }
}

#define PHASE_KERNEL(name, body) \
  __global__ void __launch_bounds__(THREADS, 2) name(Params p) { \
    __shared__ __attribute__((aligned(16))) char smem[SMEM_BYTES]; \
    const int bid = blockIdx.x, nblk = gridDim.x; (void)smem; (void)bid; (void)nblk; body; }

PHASE_KERNEL(k_prep, (phase_prep(p, smem, bid, nblk, false), phase_prep(p, smem, bid, nblk, true)))
PHASE_KERNEL(k_norm1, phase_norm(p, p.x, p.g_mix, 0, 1, false, bid, nblk))
PHASE_KERNEL(k_proj, phase_proj(p, smem, bid, nblk))
PHASE_KERNEL(k_indexer, phase_indexer(p, smem, bid, nblk))
PHASE_KERNEL(k_dilated, phase_dilated(p, smem, bid, nblk))
PHASE_KERNEL(k_sparse, phase_sparse(p, smem, bid, nblk))
PHASE_KERNEL(k_dilcomb, phase_dil_combine(p, bid, nblk))
PHASE_KERNEL(k_outproj, phase_outproj(p, smem, bid, nblk))
PHASE_KERNEL(k_norm2, phase_norm(p, p.out, p.g_ffn, 3, 4, true, bid, nblk))
PHASE_KERNEL(k_router, phase_router_sgu(p, smem, bid, nblk))
PHASE_KERNEL(k_route, phase_route_sdown(p, smem, bid, nblk))
PHASE_KERNEL(k_dispatch, phase_dispatch(p, smem, bid, nblk))
PHASE_KERNEL(k_moeup, phase_moe_up(p, smem, bid, nblk))
PHASE_KERNEL(k_moedown, phase_moe_down(p, smem, bid, nblk))
PHASE_KERNEL(k_combine, phase_combine(p, bid, nblk))

#if DEBUG_MODE == 1
__device__ float dbg_enc(float x, float base) { return base * (1.f + 9.f * fminf(1.f, log2f(1.f + x) / 20.f)); }
__global__ void k_debug_emit(Params p) {
  const u32* d = (const u32*)(p.ws + O_DBG);
  const float v1 = dbg_enc((float)d[DBG_X1], 1e6f), v2 = dbg_enc((float)d[DBG_X2], 1e5f);
  for (int i = blockIdx.x * blockDim.x + fresh_tid(); i <= 1000000; i += gridDim.x * blockDim.x) p.out[i] = i == 0 ? v1 : v2;
}
#endif

#define XB_TMO      128
#define XB_XCNT(j)  (256  + 64 * (j))
#define XB_XSUB(j)  (1280 + 64 * (j))
#define XB_XGEN(j)  (2304 + 64 * (j))
#define XB_TOP      3328
#define XB_TOPGEN   3392
#define XB_SPIN_CAP (1u << 22)
DI u32 xb_ld(u32* p) { return __hip_atomic_load(p, __ATOMIC_RELAXED, __HIP_MEMORY_SCOPE_AGENT); }
DI u32 xb_add(u32* p, u32 v) { return __hip_atomic_fetch_add(p, v, __ATOMIC_RELAXED, __HIP_MEMORY_SCOPE_AGENT); }
DI u32 xb_xcc_id() { return (u32)__builtin_amdgcn_s_getreg((3 << 11) | 20) & 0xFu; }
#define XB_SPIN(cond, bar) do { u32 _sp = 0; while (cond) { __builtin_amdgcn_s_sleep(1); \
    if ((++_sp & 255u) == 0u) { if (xb_ld(&(bar)[XB_TMO])) break; if (_sp > XB_SPIN_CAP) { atomicAdd(&(bar)[XB_TMO], 1u); break; } } } } while (0)
struct XcdBarrier { u32* bar; u32 x; volatile LDS_AS u32* st; };
DI XcdBarrier xcd_barrier_post(u32* bar, volatile LDS_AS u32* st) {
  XcdBarrier b; b.bar = bar; b.x = xb_xcc_id(); b.st = st;
  if (threadIdx.x == 0) (void)xb_add(&bar[XB_XCNT(b.x)], 1u);
  return b;
}
DI void xcd_barrier_complete(u32* bar, u32 x, u32& nloc, u32& nx) {
  const u32 G = gridDim.x;
  u32 sum, cnt, mine, sp = 0u;
  for (;;) {
    sum = 0u; cnt = 0u; mine = 0u;
#pragma unroll
    for (u32 j = 0; j < 16; ++j) { const u32 c = xb_ld(&bar[XB_XCNT(j)]); sum += c; cnt += (c > 0u) ? 1u : 0u; mine = (j == x) ? c : mine; }
    if (sum == G) break;
    __builtin_amdgcn_s_sleep(1);
    if ((++sp & 255u) == 0u) { if (xb_ld(&bar[XB_TMO])) break; if (sp > XB_SPIN_CAP) { atomicAdd(&bar[XB_TMO], 1u); break; } }
  }
  nloc = mine > 0u ? mine : 1u; nx = cnt > 0u ? cnt : 1u;
}
DI void xcd_barrier(const XcdBarrier& b) {
  asm volatile("s_waitcnt vmcnt(0)" ::: "memory");
  __syncthreads();
  if (threadIdx.x == 0) {
    u32* bar = b.bar;
    __builtin_amdgcn_s_waitcnt(0);
    u32 nloc = b.st[0], nx = b.st[1];
    if (nloc == 0u) { xcd_barrier_complete(bar, b.x, nloc, nx); b.st[0] = nloc; b.st[1] = nx; }
    const u32 old = xb_add(&bar[XB_XSUB(b.x)], 1u);
    const u32 gen = old / nloc;
    if (old + 1u == (gen + 1u) * nloc) {
      __builtin_amdgcn_fence(__ATOMIC_RELEASE, "agent");
      asm volatile("s_waitcnt vmcnt(0)" ::: "memory");
      const u32 og = xb_add(&bar[XB_TOP], 1u);
      const u32 tg = og / nx;
      if (og + 1u == (tg + 1u) * nx) xb_add(&bar[XB_TOPGEN], 1u);
      else XB_SPIN(xb_ld(&bar[XB_TOPGEN]) == tg, bar);
      __builtin_amdgcn_fence(__ATOMIC_ACQUIRE, "agent");
      xb_add(&bar[XB_XGEN(b.x)], 1u);
      asm volatile("s_waitcnt vmcnt(0)" ::: "memory");
    } else {
      XB_SPIN(xb_ld(&bar[XB_XGEN(b.x)]) == gen, bar);
      __builtin_amdgcn_fence(__ATOMIC_ACQUIRE, "agent");
      asm volatile("s_waitcnt vmcnt(0)" ::: "memory");
    }
  }
  __syncthreads();
}

__global__ void __launch_bounds__(THREADS, 2) k_mega(Params p) {
  __shared__ __attribute__((aligned(16))) char smem[SMEM_BYTES + 16];
  cg::grid_group grid = cg::this_grid();
  const int bid = blockIdx.x, nblk = gridDim.x;
  volatile LDS_AS u32* st = (volatile LDS_AS u32*)(smem + SMEM_BYTES);
  if (threadIdx.x == 0) { st[0] = 0u; st[1] = 0u; }
  __syncthreads();
  const XcdBarrier xb = xcd_barrier_post((u32*)(p.ws + O_BAR), st);
  phase_prep(p, smem, bid, nblk, false);
  grid.sync();
  phase_norm(p, p.x, p.g_mix, 0, 1, false, bid, nblk);
  xcd_barrier(xb);
  phase_proj(p, smem, bid, nblk);
  xcd_barrier(xb);
  if (((bid >> 8) ^ bid) & 1) { phase_prep(p, smem, bid, nblk, true); phase_indexer(p, smem, bid, nblk); }
  else { phase_indexer(p, smem, bid, nblk); phase_prep(p, smem, bid, nblk, true); }
  xcd_barrier(xb);
  phase_sparse(p, smem, bid, nblk);
  phase_dilated(p, smem, bid, nblk);
  xcd_barrier(xb);
  phase_dil_combine(p, bid, nblk);
  xcd_barrier(xb);
  phase_outproj(p, smem, bid, nblk);
  xcd_barrier(xb);
  phase_norm(p, p.out, p.g_ffn, 3, 4, true, bid, nblk);
  xcd_barrier(xb);
  phase_router_sgu(p, smem, bid, nblk);
  xcd_barrier(xb);
  phase_route_sdown(p, smem, bid, nblk);
  xcd_barrier(xb);
  phase_dispatch(p, smem, bid, nblk);
  xcd_barrier(xb);
  phase_moe_up(p, smem, bid, nblk);
  xcd_barrier(xb);
  phase_moe_down(p, smem, bid, nblk);
  xcd_barrier(xb);
  phase_combine(p, bid, nblk);
}
#if DEBUG_MODE == 2
__global__ void k_debug_copy(Params p) {
  for (size_t i = blockIdx.x * (size_t)blockDim.x + fresh_tid(); i < (size_t)NTOK * 1024; i += (size_t)gridDim.x * blockDim.x) {
#if DBG_BUF == 0
    p.out[i] = ((i & 1023) >= 640) ? bf2f(((const u16*)(p.ws + O_O))[i]) : 0.f;
#elif DBG_BUF == 4
    { const size_t t = i >> 10; const int c = (int)(i & 1023);
      p.out[i] = c < 384 ? bf2f(((const u16*)(p.ws + O_QB))[t * 384 + c]) : c < 768 ? bf2f(((const u16*)(p.ws + O_KB))[t * 384 + c - 384]) : bf2f(((const u16*)(p.ws + O_VB))[t * 384 + c - 768]); }
#elif DBG_BUF == 8
    { const size_t t = i >> 10; const int c = (int)(i & 1023);
      p.out[i] = c < 384 ? bf2f(((const u16*)(p.ws + O_QB))[t * 384 + c]) : c < 768 ? bf2f(((const u16*)(p.ws + O_KB))[t * 384 + c - 384]) : 0.f; }
#elif DBG_BUF == 5
    { const size_t t = i >> 10; const int c = (int)(i & 1023);
      p.out[i] = c < 384 ? bf2f(((const u16*)(p.ws + O_DNUM))[t * 384 + c]) : c < 768 ? bf2f(((const u16*)(p.ws + O_DNUM))[((size_t)NTOK + t) * 384 + c - 384]) : c < 780 ? ((const float*)(p.ws + O_DML))[t * 12 + c - 768] : 0.f; }
#elif DBG_BUF == 6
    p.out[i] = bf2f(((const u16*)(p.ws + O_H))[(i >> 10) * 2048 + (i & 1023)]);
#elif DBG_BUF == 7
    {
      if (i < 2097152) p.out[i] = ((const float*)(p.ws + O_ROPE))[i];
      else p.out[i] = 0.f; }
#elif DBG_BUF == 1
    p.out[i] = (float)((const u16*)(p.ws + O_SEL))[i % ((size_t)NTOK * 256)];
#elif DBG_BUF == 2
    p.out[i] = bf2f(((const u16*)(p.ws + O_H))[(i >> 10) * 2048 + (i & 1023)]);
#elif DBG_BUF == 3
    p.out[i] = ((const float*)(p.ws + O_LOGITS))[i % ((size_t)NTOK * 256)];
#endif
  }
}
#endif

#if DEBUG_MODE == 3
__global__ void k_check_kb(Params p) {
  const int lane = fresh_tid() & 63, wid = fresh_tid() >> 6;
  const u16* H = (const u16*)(p.ws + O_H); const u16* W = (const u16*)(p.ws + O_WT_IN);
  const u16* KB = (const u16*)(p.ws + O_KB); const float2* rope = (const float2*)(p.ws + O_ROPE);
  u32* dbg = (u32*)(p.ws + O_DBG);
  for (int row = blockIdx.x * 4 + wid; row < NTOK * 6; row += gridDim.x * 4) {
    const int tok = row / 6, hd = row % 6;
    const u16* hr = H + (size_t)tok * 2048; const u16* wr = W + (size_t)(1856 + hd * 64 + lane) * 1024;
    float a = 0.f;
    for (int k = 0; k < 1024; k += 8) {
      const u32x4 hv = *(const u32x4*)(hr + k), wv = *(const u32x4*)(wr + k);
#pragma unroll
      for (int e = 0; e < 4; ++e) { a += __uint_as_float(hv[e] << 16) * __uint_as_float(wv[e] << 16); a += __uint_as_float(hv[e] & 0xffff0000u) * __uint_as_float(wv[e] & 0xffff0000u); }
    }
    const float ss = wave_sum(a * a);
    float v = a * rsqrtf(ss * (1.f / 64.f) + EPS_) * p.knb[lane];
    const float o = __shfl_xor(v, 32);
    const float2 cs = rope[tok * 32 + (lane & 31)];
    v = lane < 32 ? v * cs.x - o * cs.y : v * cs.x + o * cs.y;
    const float got = bf2f(KB[(size_t)tok * 384 + hd * 64 + lane]);
    const bool bad = fabsf(got - v) > 0.03f + 0.02f * fabsf(v);
    const unsigned long long m = __ballot(bad);
    if (m && lane == 0) { atomicAdd(dbg + 4, 1u); const int pc = __popcll(m); if (pc >= 48) atomicAdd(dbg + 6, 1u); else if (pc <= 8) atomicAdd(dbg + 7, 1u); else atomicAdd(dbg + 8, 1u); }
  }
}
__global__ void k_check_emit(Params p) {
  const u32* d = (const u32*)(p.ws + O_DBG);
  const u32 cnt = d[4];
  const int bits1 = (cnt > 0) + 2 * (cnt > 3) + 4 * (cnt > 10) + 8 * (cnt > 30) + 16 * (cnt > 100) + 32 * (cnt > 1000);
  const int bits2 = (d[6] > 0) + 2 * (d[7] > 0) + 4 * (d[8] > 0) + 8 * (d[6] > d[7] + d[8]);
  const float c1 = (float)(10 + bits1), c2 = (float)(10 + bits2);
  const float v1 = c1 * 1e5f, v2 = c2 * 1e4f;
  for (int i = blockIdx.x * blockDim.x + fresh_tid(); i <= 1000000; i += gridDim.x * blockDim.x) p.out[i] = i == 0 ? v1 : v2;
}
#endif

#if DEBUG_MODE == 4
__global__ void k_check_sel(Params p) {
  const int tid = threadIdx.x;
  const u16* QI = (const u16*)(p.ws + O_QI); const u16* KI = (const u16*)(p.ws + O_KI); const float* WI = (const float*)(p.ws + O_WI);
  const u16* SEL = (const u16*)(p.ws + O_SEL); const int* SELCNT = (const int*)(p.ws + O_SELCNT);
  u32* dbg = (u32*)(p.ws + O_DBG);
  float* scr = (float*)(p.ws + O_LOGITS) + (size_t)blockIdx.x * 8192;
  __shared__ int s_bad;
  for (int sidx = blockIdx.x; sidx < 1024; sidx += gridDim.x) {
    const int b = sidx & 3, t = ((int)(((long long)(sidx >> 2) * 8191) / 255) & ~7) + DBG_TMOD, tok = b * S_ + t;
    if (tid == 0) s_bad = 0;
    __syncthreads();
    for (int k = tid; k <= t; k += blockDim.x) {
      float sc = 0.f;
      for (int h = 0; h < 8; ++h) {
        float d = 0.f;
        for (int e = 0; e < 64; ++e) d += bf2f(QI[(size_t)tok * 512 + h * 64 + e]) * bf2f(KI[(size_t)(b * S_ + k) * 64 + e]);
        sc += WI[tok * 8 + h] * fmaxf(d, 0.f);
      }
      scr[k] = sc;
    }
    __syncthreads();
    const int cnt = SELCNT[tok], want = min(t + 1, NSEL);
    int bad = 0;
    if (tid == 0 && cnt != want) atomicAdd(dbg + 6, 1u);
    if (tid < cnt && tid < NSEL) {
      const int key = SEL[(size_t)tok * NSEL + tid];
      if (key > t) bad += 1;
      else {
        const float sk = scr[key]; int rank = 0;
        for (int k = 0; k <= t; ++k) rank += (scr[k] > sk || (scr[k] == sk && k < key)) ? 1 : 0;
        if (rank >= NSEL + 2) { bad += 1; atomicMax(dbg + 7, (u32)rank); }
        for (int j = 0; j < tid; ++j) if (SEL[(size_t)tok * NSEL + j] == key) { bad += 1; break; }
      }
    }
    if (bad) atomicAdd(&s_bad, bad);
    __syncthreads();
    if (tid == 0 && s_bad) { atomicAdd(dbg + 4, (u32)s_bad); atomicAdd(dbg + 5, 1u); }
    __syncthreads();
  }
}
__device__ float dbg_enc2(float x, float base) { return base * (1.f + 9.f * fminf(1.f, log2f(1.f + x) / 20.f)); }
__global__ void k_check_emit4(Params p) {
  const u32* d = (const u32*)(p.ws + O_DBG);
  const float v1 = dbg_enc2((float)d[7], 1e6f), v2 = dbg_enc2((float)d[4], 1e5f);
  for (int i = blockIdx.x * blockDim.x + threadIdx.x; i < NTOK * 1024; i += gridDim.x * blockDim.x) p.out[i] = i == 0 ? v1 : (i <= 1000000 ? v2 : 0.f);
}
#endif
extern "C" void kernel_launch(void* const* d_in, const int* in_sizes, int n_in, void* d_out, int out_size, void* d_ws, size_t ws_size,
                              hipStream_t stream) {
  Params p{};
  p.x = (const float*)d_in[0]; p.c = (const float*)d_in[1]; p.pos = (const int*)d_in[2];
  p.w_ada = (const float*)d_in[3]; p.b_ada = (const float*)d_in[4]; p.g_mix = (const float*)d_in[5]; p.w_in = (const float*)d_in[6];
  p.qna = (const float*)d_in[7]; p.kna = (const float*)d_in[8]; p.qnb = (const float*)d_in[9]; p.knb = (const float*)d_in[10];
  p.w_out = (const float*)d_in[11]; p.g_ffn = (const float*)d_in[12]; p.w_router = (const float*)d_in[13]; p.rbias = (const float*)d_in[14];
  p.w_gate = (const float*)d_in[15]; p.w_up = (const float*)d_in[16]; p.w_down = (const float*)d_in[17];
  p.ws_gate = (const float*)d_in[18]; p.ws_up = (const float*)d_in[19]; p.ws_down = (const float*)d_in[20];
  p.out = (float*)d_out; p.ws = (char*)d_ws;
  if (ws_size < WS_TOTAL) { fprintf(stderr, "workspace too small: %zu < %zu\n", ws_size, (size_t)WS_TOTAL); return; }
  (void)hipMemsetAsync(d_ws, 0, ZERO_BYTES, stream);
#if MEGA && DEBUG_MODE != 4 && DEBUG_MODE != 5
  static int grid_blocks = 0;
  if (!grid_blocks) {
    int dev = 0, cus = 0, per_cu = 0;
    (void)hipGetDevice(&dev);
    (void)hipDeviceGetAttribute(&cus, hipDeviceAttributeMultiprocessorCount, dev);
    (void)hipOccupancyMaxActiveBlocksPerMultiprocessor(&per_cu, k_mega, THREADS, 0);
    if (per_cu > 2) per_cu = 2;
    grid_blocks = cus * per_cu;
    grid_blocks -= grid_blocks % 8;
  }
  void* args[] = {&p};
  hipError_t e = hipLaunchCooperativeKernel((void*)k_mega, dim3(grid_blocks), dim3(THREADS), args, 0, stream);
  if (e != hipSuccess) fprintf(stderr, "cooperative launch failed: %s (grid %d)\n", hipGetErrorString(e), grid_blocks);
#else
  const dim3 g(2048), t(THREADS);
  k_prep<<<g, t, 0, stream>>>(p);
  k_norm1<<<g, t, 0, stream>>>(p);
  k_proj<<<g, t, 0, stream>>>(p);
  k_indexer<<<dim3(1024), t, 0, stream>>>(p);
#if DEBUG_MODE == 4
  k_check_sel<<<512, 256, 0, stream>>>(p); k_check_emit4<<<256, 256, 0, stream>>>(p); return;
#endif
  k_dilated<<<g, t, 0, stream>>>(p);
  k_sparse<<<g, t, 0, stream>>>(p);
  k_dilcomb<<<g, t, 0, stream>>>(p);
  k_outproj<<<g, t, 0, stream>>>(p);
  k_norm2<<<g, t, 0, stream>>>(p);
  k_router<<<g, t, 0, stream>>>(p);
  k_route<<<g, t, 0, stream>>>(p);
  k_dispatch<<<g, t, 0, stream>>>(p);
  k_moeup<<<g, t, 0, stream>>>(p);
  k_moedown<<<g, t, 0, stream>>>(p);
  k_combine<<<g, t, 0, stream>>>(p);
#endif
}
```

```cpp
#include <hip/hip_runtime.h>
#include <hip/hip_cooperative_groups.h>
#include <stdint.h>
#include <stdio.h>
namespace cg = cooperative_groups;

typedef unsigned short u16;
typedef unsigned int u32;
typedef unsigned long long u64;
typedef __attribute__((ext_vector_type(8))) short bf16x8;
typedef __attribute__((ext_vector_type(4))) short s16x4;
typedef __attribute__((ext_vector_type(4))) float f32x4;
typedef __attribute__((ext_vector_type(16))) float f32x16;
typedef __attribute__((ext_vector_type(2))) float f32x2;
typedef __attribute__((ext_vector_type(4))) u32 u32x4;
typedef __attribute__((ext_vector_type(2))) u32 u32x2;
typedef __attribute__((ext_vector_type(2))) __bf16 bf16x2_t;
#define DI __device__ __forceinline__
#define LDS_AS __attribute__((address_space(3)))

#ifndef MEGA
#define MEGA 1
#endif
#ifndef DEBUG_MODE
#define DEBUG_MODE 0
#endif
#define DBG_TMOD 0
#define DBG_SUB 0
#define DBG_BUF 8
#define DBG_X1 2
#define DBG_X2 1
constexpr int NB_ = 4, S_ = 8192, D_ = 1024, NTOK = NB_ * S_;
constexpr int DIN_PAD = 2688;
constexpr int NEXP = 256, TOPK = 8, DEXP = 256;
constexpr int NSLOT = NTOK * TOPK;
constexpr float EPS_ = 1e-6f;
constexpr int NSEL = 256;
constexpr int THREADS = 256;
constexpr int SMEM_BYTES = 80384;

constexpr size_t al256(size_t x) { return (x + 255) & ~size_t(255); }
constexpr size_t O_CNT = 0;
constexpr size_t O_KMAX = 1024;
constexpr size_t O_DBG = 2048;
constexpr size_t O_BAR = 4096;
constexpr size_t ZERO_BYTES = 32768;
constexpr size_t O_MOD = 32768;
constexpr size_t O_WT_IN = O_MOD + al256(4 * 6144 * 4);
constexpr size_t O_WT_OUT = O_WT_IN + (size_t)DIN_PAD * 1024 * 2;
constexpr size_t O_WT_RT = O_WT_OUT + (size_t)1024 * 1024 * 2;
constexpr size_t O_WT_SGU = O_WT_RT + (size_t)256 * 3072 * 2;
constexpr size_t O_WT_SD = O_WT_SGU + (size_t)512 * 1024 * 2;
constexpr size_t O_ROPE = O_WT_SD + (size_t)1024 * 256 * 2;
constexpr size_t O_SELE = O_ROPE + (size_t)NTOK * 32 * 8;
constexpr size_t O_GATE = O_SELE + (size_t)NTOK * 8 * 4;
constexpr size_t O_POSE = O_GATE + (size_t)NTOK * 8 * 4;
constexpr size_t O_TOKSLOT = O_POSE + (size_t)NTOK * 8 * 4;
constexpr size_t O_SLOTTOK = O_TOKSLOT + (size_t)NTOK * 8 * 4;
constexpr size_t O_SLOTGATE = O_SLOTTOK + (size_t)NSLOT * 4;
constexpr size_t O_SELCNT = O_SLOTGATE + (size_t)NSLOT * 4;
constexpr size_t O_LOGITS = O_SELCNT + (size_t)NTOK * 4;
constexpr size_t O_ACTS = O_LOGITS + (size_t)NTOK * 256 * 4;
constexpr size_t O_WT_ED = O_ACTS + (size_t)NTOK * 256 * 2;
constexpr size_t O_O = O_WT_ED + (size_t)NEXP * 1024 * 256 * 2;
constexpr size_t O_DNUM = O_O + (size_t)NTOK * 1024 * 2;
constexpr size_t O_DML = O_DNUM + (size_t)3 * NTOK * 384 * 2;
constexpr size_t O_ACT = O_DML + (size_t)3 * NTOK * 6 * 2 * 4;
constexpr size_t O_QB = O_ACT;
constexpr size_t O_KB = O_QB + (size_t)NTOK * 384 * 2;
constexpr size_t O_VB = O_KB + (size_t)NTOK * 384 * 2;
constexpr size_t O_SEL = O_VB + (size_t)NTOK * 384 * 2;
constexpr size_t O_BIG = O_ACT + (size_t)NSLOT * 256 * 2;
constexpr size_t O_WT_EGU = O_BIG;
constexpr size_t O_H = O_WT_EGU + (size_t)NEXP * 512 * 1024 * 2;
constexpr size_t O_QA = O_H + (size_t)NTOK * 2048 * 2;
constexpr size_t O_KV = O_QA + (size_t)NTOK * 640 * 2;
constexpr size_t O_QI = O_KV + (size_t)NTOK * 256 * 2;
constexpr size_t O_KI = O_QI + (size_t)NTOK * 512 * 2;
constexpr size_t O_WI = O_KI + (size_t)NTOK * 64 * 2;
constexpr size_t O_BIG_USED = O_WI + (size_t)NTOK * 8 * 4;
constexpr size_t O_DNUM2 = O_H;
constexpr size_t O_DML2 = O_H + (size_t)3 * NTOK * 384 * 2;
static_assert(O_DML2 + (size_t)3 * NTOK * 6 * 2 * 4 <= O_QA, "dilated buffers do not fit the H region");
constexpr size_t O_X1 = O_DNUM;
static_assert((size_t)NTOK * 1024 * 2 <= (size_t)3 * NTOK * 384 * 2, "x1 does not fit");
constexpr size_t O_Y9 = O_QA;
static_assert((size_t)NTOK * 1024 <= (size_t)NTOK * 640 * 2, "Y9 does not fit the QA region");
constexpr size_t WS_TOTAL = O_BIG + (size_t)NSLOT * 1024 * 2;
static_assert(O_BIG_USED <= WS_TOTAL, "overlay too large");
static_assert(O_SEL + (size_t)NTOK * 256 * 2 <= O_BIG, "act overlay too large");

struct Params {
  const float *x, *c; const int* pos;
  const float *w_ada, *b_ada, *g_mix, *w_in, *qna, *kna, *qnb, *knb, *w_out, *g_ffn, *w_router, *rbias,
              *w_gate, *w_up, *w_down, *ws_gate, *ws_up, *ws_down;
  float* out; char* ws;
};

DI int fresh_tid() { int t = threadIdx.x; asm volatile("" : "+v"(t)); return t; }
DI float bf2f(u16 h) { return __uint_as_float(((u32)h) << 16); }
DI u16 f2bf(float f) { return __builtin_bit_cast(u16, (__bf16)f); }
constexpr float YSCALE = 256.f;
DI u32 pack4_fp8(f32x4 v) {
  int w = 0;
  w = __builtin_amdgcn_cvt_pk_fp8_f32(__builtin_amdgcn_fmed3f(v[0], -448.f, 448.f), __builtin_amdgcn_fmed3f(v[1], -448.f, 448.f), w, false);
  w = __builtin_amdgcn_cvt_pk_fp8_f32(__builtin_amdgcn_fmed3f(v[2], -448.f, 448.f), __builtin_amdgcn_fmed3f(v[3], -448.f, 448.f), w, true);
  return (u32)w;
}
DI u32 pack2(float a, float b) { f32x2 v = {a, b}; return __builtin_bit_cast(u32, __builtin_convertvector(v, bf16x2_t)); }
DI bf16x8 pack8(float a0, float a1, float a2, float a3, float a4, float a5, float a6, float a7) {
  u32x4 p = {pack2(a0, a1), pack2(a2, a3), pack2(a4, a5), pack2(a6, a7)};
  return __builtin_bit_cast(bf16x8, p);
}
DI float wave_sum(float v) { for (int o = 32; o > 0; o >>= 1) v += __shfl_xor(v, o); return v; }
#define DPP_ADD(v, ctrl) ((v) + __builtin_bit_cast(float, __builtin_amdgcn_update_dpp(0, __builtin_bit_cast(int, (v)), (ctrl), 0xf, 0xf, true)))
DI float row16_sum(float v) {
  v = DPP_ADD(v, 0xB1);
  v = DPP_ADD(v, 0x4E);
  v = DPP_ADD(v, 0x141);
  v = DPP_ADD(v, 0x140);
  return v;
}
DI float silu_f(float v) { return v / (1.f + __expf(-v)); }
DI float sigmoid_f(float v) { return 1.f / (1.f + __expf(-v)); }
DI void glds16(const void* g, void* l) {
  __builtin_amdgcn_global_load_lds((const u32*)g, (LDS_AS u32*)l, 16, 0, 0);
}
#define MFMA16(a, b, c) __builtin_amdgcn_mfma_f32_16x16x32_bf16((a), (b), (c), 0, 0, 0)
#define MFMA32(a, b, c) __builtin_amdgcn_mfma_f32_32x32x16_bf16((a), (b), (c), 0, 0, 0)
DI s16x4 tr_read(const void* l) { return __builtin_amdgcn_ds_read_tr16_b64_v4i16((LDS_AS s16x4*)l); }

DI int rowmap(int mode, int n) {
  if (mode == 1) return n < 1472 ? n : (n < 1480 ? n - 1472 + 2624 : n - 8);
  if (mode == 2) return 64 * (n >> 5) + (n & 31);
  if (mode == 3) return 64 * (n >> 5) + (n & 31) + 32;
  return n;
}
__device__ __forceinline__ void transpose_tiles4(char* smem, const float* src, int ldn, int nvalid, int ntn, int t0, u16* dst, int ldk, int mode) {
  const int tid = fresh_tid();
  float4 v[4][4];
#pragma unroll
  for (int q = 0; q < 4; ++q) {
    const int t = t0 + q, k0 = (t / ntn) * 64, n0 = (t % ntn) * 64;
#pragma unroll
    for (int i = 0; i < 4; ++i) {
      const int k = (tid >> 4) + 16 * i, n = (tid & 15) * 4;
      v[q][i] = make_float4(0.f, 0.f, 0.f, 0.f);
      if (n0 + n + 3 < nvalid) { const f32x4 t4 = __builtin_nontemporal_load((const f32x4*)(src + (size_t)(k0 + k) * ldn + n0 + n)); v[q][i] = make_float4(t4[0], t4[1], t4[2], t4[3]); }
      else { float tt[4] = {0.f, 0.f, 0.f, 0.f};
        for (int e = 0; e < 4; ++e) if (n0 + n + e < nvalid) tt[e] = src[(size_t)(k0 + k) * ldn + n0 + n + e];
        v[q][i] = make_float4(tt[0], tt[1], tt[2], tt[3]); }
    }
  }
  __syncthreads();
#pragma unroll
  for (int q = 0; q < 4; ++q) {
    float* tile = (float*)smem + q * (64 * 65);
#pragma unroll
    for (int i = 0; i < 4; ++i) {
      const int k = (tid >> 4) + 16 * i, n = (tid & 15) * 4;
      tile[k * 65 + n] = v[q][i].x; tile[k * 65 + n + 1] = v[q][i].y; tile[k * 65 + n + 2] = v[q][i].z; tile[k * 65 + n + 3] = v[q][i].w;
    }
  }
  __syncthreads();
  const int nr = tid >> 2, ks = (tid & 3) * 16;
#pragma unroll
  for (int q = 0; q < 4; ++q) {
    const int t = t0 + q, k0 = (t / ntn) * 64, n0 = (t % ntn) * 64;
    const float* tile = (const float*)smem + q * (64 * 65);
    if (n0 + nr < nvalid) {
      float f[16];
#pragma unroll
      for (int j = 0; j < 16; ++j) f[j] = tile[(ks + j) * 65 + nr];
      const u32x4 lo4 = (u32x4){pack2(f[0], f[1]), pack2(f[2], f[3]), pack2(f[4], f[5]), pack2(f[6], f[7])};
      const u32x4 hi4 = (u32x4){pack2(f[8], f[9]), pack2(f[10], f[11]), pack2(f[12], f[13]), pack2(f[14], f[15])};
      u16* d = dst + (size_t)rowmap(mode, n0 + nr) * ldk + k0 + ks;
      __builtin_nontemporal_store(lo4, (u32x4*)d); __builtin_nontemporal_store(hi4, (u32x4*)(d + 8));
      if (mode == 4) {
        float g[16];
#pragma unroll
        for (int j = 0; j < 16; ++j) g[j] = f[j] - bf2f(f2bf(f[j]));
        const u32x4 l0 = (u32x4){pack2(g[0], g[1]), pack2(g[2], g[3]), pack2(g[4], g[5]), pack2(g[6], g[7])};
        const u32x4 l1 = (u32x4){pack2(g[8], g[9]), pack2(g[10], g[11]), pack2(g[12], g[13]), pack2(g[14], g[15])};
        *(u32x4*)(d + 1024) = l0; *(u32x4*)(d + 1024 + 8) = l1;
        *(u32x4*)(d + 2048) = lo4; *(u32x4*)(d + 2048 + 8) = hi4;
      }
    }
  }
}

constexpr int PREP_T_IN = 16 * 42 / 4, PREP_T_OUT = 256 / 4, PREP_T_RT = 64 / 4, PREP_T_SG = 64 / 4, PREP_T_SU = 64 / 4, PREP_T_SD = 64 / 4;
constexpr int PREP_T_E = NEXP * 64 / 4;
constexpr int PREP_B0 = 0, PREP_B1 = PREP_B0 + PREP_T_IN, PREP_B2 = PREP_B1 + PREP_T_OUT, PREP_B3 = PREP_B2 + PREP_T_RT,
              PREP_B4 = PREP_B3 + PREP_T_SG, PREP_B5 = PREP_B4 + PREP_T_SU, PREP_B6 = PREP_B5 + PREP_T_SD,
              PREP_B7 = PREP_B6 + PREP_T_E, PREP_B8 = PREP_B7 + PREP_T_E, PREP_B9 = PREP_B8 + PREP_T_E;
constexpr int PREP_MOD = 96, PREP_ROPE = NTOK * 32 / 256, PREP_PAD = 1;
constexpr int PREP_ITEMS = PREP_B9 + PREP_MOD + PREP_ROPE + PREP_PAD;

__device__ __forceinline__ void phase_prep(const Params& p, char* smem, int bid, int nblk, bool experts, int part = 0) {
  char* ws = p.ws;
  const int tid = fresh_tid();
  for (int it = (experts ? PREP_B6 : 0) + bid; it < (experts ? PREP_B9 : PREP_ITEMS); it += nblk) {
    if (!experts && it >= PREP_B6 && it < PREP_B9) continue;
    if (part == 1 && !(it >= PREP_B9 && it < PREP_B9 + PREP_MOD)) continue;
    if (part == 2 && it >= PREP_B9 && it < PREP_B9 + PREP_MOD) continue;
    if (it < PREP_B1) { transpose_tiles4(smem, p.w_in, 2632, 2632, 42, (it - PREP_B0) * 4, (u16*)(ws + O_WT_IN), 1024, 1); }
    else if (it < PREP_B2) { transpose_tiles4(smem, p.w_out, 1024, 1024, 16, (it - PREP_B1) * 4, (u16*)(ws + O_WT_OUT), 1024, 0); }
    else if (it < PREP_B3) { transpose_tiles4(smem, p.w_router, 256, 256, 4, (it - PREP_B2) * 4, (u16*)(ws + O_WT_RT), 3072, 4); }
    else if (it < PREP_B4) { transpose_tiles4(smem, p.ws_gate, 256, 256, 4, (it - PREP_B3) * 4, (u16*)(ws + O_WT_SGU), 1024, 2); }
    else if (it < PREP_B5) { transpose_tiles4(smem, p.ws_up, 256, 256, 4, (it - PREP_B4) * 4, (u16*)(ws + O_WT_SGU), 1024, 3); }
    else if (it < PREP_B6) { transpose_tiles4(smem, p.ws_down, 1024, 1024, 16, (it - PREP_B5) * 4, (u16*)(ws + O_WT_SD), 256, 0); }
    else if (it < PREP_B7) { const int t = it - PREP_B6, e = t >> 4;
      transpose_tiles4(smem, p.w_gate + (size_t)e * 1024 * 256, 256, 256, 4, (t & 15) * 4, (u16*)(ws + O_WT_EGU) + (size_t)e * 512 * 1024, 1024, 2); }
    else if (it < PREP_B8) { const int t = it - PREP_B7, e = t >> 4;
      transpose_tiles4(smem, p.w_up + (size_t)e * 1024 * 256, 256, 256, 4, (t & 15) * 4, (u16*)(ws + O_WT_EGU) + (size_t)e * 512 * 1024, 1024, 3); }
    else if (it < PREP_B9) { const int t = it - PREP_B8, e = t >> 4;
      transpose_tiles4(smem, p.w_down + (size_t)e * 256 * 1024, 1024, 1024, 16, (t & 15) * 4, (u16*)(ws + O_WT_ED) + (size_t)e * 1024 * 256, 256, 0); }
    else if (it < PREP_B9 + PREP_MOD) {
      const int n = (it - PREP_B9) * 64 + (tid & 63), kg = tid >> 6;
      float* sl = (float*)smem;
      __syncthreads();
      for (int i = tid; i < 4096; i += 256) sl[i] = silu_f(p.c[i]);
      __syncthreads();
      float a0 = 0.f, a1 = 0.f, a2 = 0.f, a3 = 0.f;
#pragma unroll 8
      for (int k = kg; k < 1024; k += 4) {
        float w = p.w_ada[(size_t)k * 6144 + n];
        a0 += sl[k] * w; a1 += sl[1024 + k] * w; a2 += sl[2048 + k] * w; a3 += sl[3072 + k] * w;
      }
      __syncthreads();
      float* ps = sl + 4096;
      ps[(kg * 4 + 0) * 64 + (tid & 63)] = a0; ps[(kg * 4 + 1) * 64 + (tid & 63)] = a1;
      ps[(kg * 4 + 2) * 64 + (tid & 63)] = a2; ps[(kg * 4 + 3) * 64 + (tid & 63)] = a3;
      __syncthreads();
      { const int b = tid >> 6, c = tid & 63;
        float s = p.b_ada[(it - PREP_B9) * 64 + c];
        for (int g = 0; g < 4; ++g) s += ps[(g * 4 + b) * 64 + c];
        ((float*)(ws + O_MOD))[b * 6144 + (it - PREP_B9) * 64 + c] = s; }
    }
    else if (it < PREP_B9 + PREP_MOD + PREP_ROPE) {
      const int idx = (it - PREP_B9 - PREP_MOD) * 256 + tid, tok = idx >> 5, i = idx & 31;
      const float inv = (float)exp(-(double)i * (9.210340371976184 / 32.0));
      const float ang = (float)p.pos[tok] * inv;
      double t = (double)ang * 0.15915494309189535; t -= rint(t);
      const float fr = (float)t;
      float2 cs = make_float2(__builtin_amdgcn_cosf(fr), __builtin_amdgcn_sinf(fr));
      ((float2*)(ws + O_ROPE))[idx] = cs;
    }
    else {
      u32* d = (u32*)((u16*)(ws + O_WT_IN) + (size_t)2632 * 1024);
      for (int i = tid; i < 56 * 512; i += 256) d[i] = 0u;
    }
  }
}


struct TJob { const float* src; int ldn, lgn, t0; u16* dst; int ldk, mode; };
DI TJob expert_job(const Params& p, int it) {
  char* ws = p.ws; TJob j;
  if (it < PREP_B7) { const int t = it - PREP_B6, e = t >> 4;
    j.src = p.w_gate + (size_t)e * 1024 * 256; j.ldn = 256; j.lgn = 2; j.t0 = (t & 15) * 4; j.dst = (u16*)(ws + O_WT_EGU) + (size_t)e * 512 * 1024; j.ldk = 1024; j.mode = 2; }
  else if (it < PREP_B8) { const int t = it - PREP_B7, e = t >> 4;
    j.src = p.w_up + (size_t)e * 1024 * 256; j.ldn = 256; j.lgn = 2; j.t0 = (t & 15) * 4; j.dst = (u16*)(ws + O_WT_EGU) + (size_t)e * 512 * 1024; j.ldk = 1024; j.mode = 3; }
  else { const int t = it - PREP_B8, e = t >> 4;
    j.src = p.w_down + (size_t)e * 256 * 1024; j.ldn = 1024; j.lgn = 4; j.t0 = (t & 15) * 4; j.dst = (u16*)(ws + O_WT_ED) + (size_t)e * 1024 * 256; j.ldk = 256; j.mode = 0; }
  return j;
}
DI void tt_load(const TJob& j, f32x4 (&v)[4][4]) {
  const int tid = fresh_tid();
#pragma unroll
  for (int q = 0; q < 4; ++q) {
    const int t = j.t0 + q, k0 = (t >> j.lgn) * 64, n0 = (t & ((1 << j.lgn) - 1)) * 64;
#pragma unroll
    for (int i = 0; i < 4; ++i)
      v[q][i] = __builtin_nontemporal_load((const f32x4*)(j.src + (size_t)(k0 + (tid >> 4) + 16 * i) * j.ldn + n0 + (tid & 15) * 4));
  }
}
DI void tt_store(char* smem, const TJob& j, const f32x4 (&v)[4][4]) {
  const int tid = fresh_tid();
  __syncthreads();
#pragma unroll
  for (int q = 0; q < 4; ++q) {
    float* tile = (float*)smem + q * (64 * 65);
#pragma unroll
    for (int i = 0; i < 4; ++i) {
      const int k = (tid >> 4) + 16 * i, n = (tid & 15) * 4;
      tile[k * 65 + n] = v[q][i][0]; tile[k * 65 + n + 1] = v[q][i][1]; tile[k * 65 + n + 2] = v[q][i][2]; tile[k * 65 + n + 3] = v[q][i][3];
    }
  }
  __syncthreads();
  const int nr = tid >> 2, ks = (tid & 3) * 16;
#pragma unroll
  for (int q = 0; q < 4; ++q) {
    const int t = j.t0 + q, k0 = (t >> j.lgn) * 64, n0 = (t & ((1 << j.lgn) - 1)) * 64;
    const float* tile = (const float*)smem + q * (64 * 65);
    float f[16];
#pragma unroll
    for (int jj = 0; jj < 16; ++jj) f[jj] = tile[(ks + jj) * 65 + nr];
    const u32x4 lo4 = (u32x4){pack2(f[0], f[1]), pack2(f[2], f[3]), pack2(f[4], f[5]), pack2(f[6], f[7])};
    const u32x4 hi4 = (u32x4){pack2(f[8], f[9]), pack2(f[10], f[11]), pack2(f[12], f[13]), pack2(f[14], f[15])};
    u16* d = j.dst + (size_t)rowmap(j.mode, n0 + nr) * j.ldk + k0 + ks;
    __builtin_nontemporal_store(lo4, (u32x4*)d); __builtin_nontemporal_store(hi4, (u32x4*)(d + 8));
  }
}
__device__ __forceinline__ void phase_conv_experts(const Params& p, char* smem, int bid, int nblk) {
  int it = PREP_B6 + bid;
  if (it >= PREP_B9) return;
  TJob cur = expert_job(p, it);
  f32x4 va[4][4];
  tt_load(cur, va);
  while (true) {
    const int itn = it + nblk; const bool hn = itn < PREP_B9;
    TJob nx = cur; f32x4 vb[4][4];
    if (hn) { nx = expert_job(p, itn); tt_load(nx, vb); }
    tt_store(smem, cur, va);
    if (!hn) break;
#pragma unroll
    for (int q = 0; q < 4; ++q)
#pragma unroll
      for (int i = 0; i < 4; ++i) va[q][i] = vb[q][i];
    cur = nx; it = itn;
  }
}

__device__ __forceinline__ void phase_norm(const Params& p, const float* src, const u16* src16, const float* gain, int shc, int scc, bool write_lo, int bid, int nblk) {
  const int lane = fresh_tid() & 63, wid = fresh_tid() >> 6;
  const float* mod = (const float*)(p.ws + O_MOD);
  u16* H = (u16*)(p.ws + O_H);
  for (int it = bid; it < NTOK / 16; it += nblk) {
    const int tok0 = it * 16 + wid * 4, b = tok0 >> 13;
    f32x4 v[4][4];
    if (src16) {
#pragma unroll
      for (int r = 0; r < 4; ++r)
#pragma unroll
        for (int j = 0; j < 2; ++j) {
          const u32x4 w = *(const u32x4*)(src16 + (size_t)(tok0 + r) * 1024 + lane * 8 + 512 * j);
          v[r][2 * j] = (f32x4){__uint_as_float(w[0] << 16), __uint_as_float(w[0] & 0xffff0000u), __uint_as_float(w[1] << 16), __uint_as_float(w[1] & 0xffff0000u)};
          v[r][2 * j + 1] = (f32x4){__uint_as_float(w[2] << 16), __uint_as_float(w[2] & 0xffff0000u), __uint_as_float(w[3] << 16), __uint_as_float(w[3] & 0xffff0000u)};
        }
    } else {
#pragma unroll
      for (int r = 0; r < 4; ++r)
#pragma unroll
        for (int q = 0; q < 4; ++q) v[r][q] = __builtin_nontemporal_load((const f32x4*)(src + (size_t)(tok0 + r) * 1024 + lane * 8 + 512 * (q >> 1) + 4 * (q & 1)));
    }
    f32x4 ga[4], sh[4];
#pragma unroll
    for (int q = 0; q < 4; ++q) {
      const int col = lane * 8 + 512 * (q >> 1) + 4 * (q & 1);
      const f32x4 g = *(const f32x4*)(gain + col), sc = *(const f32x4*)(mod + b * 6144 + scc * 1024 + col);
      sh[q] = *(const f32x4*)(mod + b * 6144 + shc * 1024 + col);
      ga[q] = g * (1.f + sc);
    }
#pragma unroll
    for (int r = 0; r < 4; ++r) {
      float ss = 0.f;
#pragma unroll
      for (int q = 0; q < 4; ++q)
#pragma unroll
        for (int e = 0; e < 4; ++e) ss = fmaf(v[r][q][e], v[r][q][e], ss);
      ss = wave_sum(ss);
      const float rstd = rsqrtf(ss * (1.f / 1024.f) + EPS_);
      u16* hr = H + (size_t)(tok0 + r) * 2048 + lane * 8;
#pragma unroll
      for (int j = 0; j < 2; ++j) {
        const f32x4 h0 = v[r][2 * j] * rstd * ga[2 * j] + sh[2 * j], h1 = v[r][2 * j + 1] * rstd * ga[2 * j + 1] + sh[2 * j + 1];
        const u32x4 hi = {pack2(h0[0], h0[1]), pack2(h0[2], h0[3]), pack2(h1[0], h1[1]), pack2(h1[2], h1[3])};
        *(u32x4*)(hr + 512 * j) = hi;
        if (write_lo) {
          const u32x4 lo = {pack2(h0[0] - __uint_as_float(hi[0] << 16), h0[1] - __uint_as_float(hi[0] & 0xffff0000u)),
                            pack2(h0[2] - __uint_as_float(hi[1] << 16), h0[3] - __uint_as_float(hi[1] & 0xffff0000u)),
                            pack2(h1[0] - __uint_as_float(hi[2] << 16), h1[1] - __uint_as_float(hi[2] & 0xffff0000u)),
                            pack2(h1[2] - __uint_as_float(hi[3] << 16), h1[3] - __uint_as_float(hi[3] & 0xffff0000u))};
          *(u32x4*)(hr + 1024 + 512 * j) = lo;
        }
      }
    }
  }
}

struct GDesc { const u16* A; const u16* B; u32 aoffs[8]; u32 boff0, ldb; int split; };
template <class ARow>
DI GDesc g_make(const u16* A, ARow arow, const u16* B, int ldb, int split) {
  const int lane = fresh_tid() & 63, gsrc = (0x78 >> (2 * ((lane >> 4) & 3))) & 3;
  GDesc d; d.A = A; d.B = B; d.ldb = (u32)ldb; d.split = split;
#pragma unroll
  for (int i = 0; i < 8; ++i) d.aoffs[i] = (u32)arow(16 * i + (lane >> 2)) + ((lane & 3) ^ gsrc) * 8;
  d.boff0 = (u32)(lane >> 2) * (u32)ldb + ((lane & 3) ^ gsrc) * 8;
  return d;
}
DI void g_stage(char* smem, const GDesc& d, int t) {
  const int lane = fresh_tid() & 63;
  char* base = smem + (t & 3) * 16384 + lane * 16;
  const int ko = (d.split && t >= 32) ? t * 32 - 1024 : t * 32;
#pragma unroll
  for (int i = 0; i < 8; ++i) glds16(d.A + d.aoffs[i] + ko, base + i * 1024);
#pragma unroll
  for (int i = 0; i < 8; ++i) glds16(d.B + d.boff0 + (u32)(16 * i) * d.ldb + t * 32, base + 8192 + i * 1024);
}
DI void g_begin(char* smem, const GDesc& d, int nkt) {
  const int wid = __builtin_amdgcn_readfirstlane(fresh_tid() >> 6);
  __syncthreads();
  if (wid < 3 && wid < nkt) g_stage(smem, d, wid);
}
template <int ABL = 0>
DI void g_run(char* smem, const GDesc& d, int nkt, bool has_next, const GDesc& nx, f32x4 (&acc)[4][4]) {
  const int tid = fresh_tid(), lane = tid & 63, wid = __builtin_amdgcn_readfirstlane(tid >> 6), wr = wid >> 1, wc = wid & 1, fr = lane & 15, fq = lane >> 4;
  const int grd = (0x78 >> (2 * ((fr >> 2) & 3))) & 3, rdq = (fq ^ grd) * 16;
#pragma unroll
  for (int m = 0; m < 4; ++m)
#pragma unroll
    for (int n = 0; n < 4; ++n) acc[m][n] = (f32x4){0.f, 0.f, 0.f, 0.f};
  for (int t = 0; t < nkt; ++t) {
    if (wid == (t & 3)) asm volatile("s_waitcnt vmcnt(0)" ::: "memory");
    asm volatile("s_waitcnt lgkmcnt(0)" ::: "memory");
    __builtin_amdgcn_s_barrier();
    const int g = t + 3;
    if (!(ABL & 1) && wid == (g & 3)) { if (g < nkt) g_stage(smem, d, g); else if (has_next) g_stage(smem, nx, g - nkt); }
    const char* base = smem + (t & 3) * 16384;
    bf16x8 At[4], Bt[4];
#pragma unroll
    for (int m = 0; m < 4; ++m) At[m] = *(const bf16x8*)(base + (wr * 64 + m * 16 + fr) * 64 + rdq);
#pragma unroll
    for (int n = 0; n < 4; ++n) Bt[n] = *(const bf16x8*)(base + 8192 + (wc * 64 + n * 16 + fr) * 64 + rdq);
#pragma unroll
    for (int m = 0; m < 4; ++m)
#pragma unroll
      for (int n = 0; n < 4; ++n) acc[m][n] = MFMA16(Bt[n], At[m], acc[m][n]);
  }
}

struct G2Desc { const u16* A; const u16* B; u32 lda, ldb; int rmax; const u32* tab; int bperm; int split; };
DI u32 g2_brow(int bperm, int i, int lr) {
  if (bperm == 1) return (u32)((i >> 2) * 64 + 16 * (lr >> 2) + 4 * (i & 3) + (lr & 3));
  if (bperm == 2) return (u32)((i >> 2) * 64 + 32 * ((i & 3) >> 1) + 8 * (lr >> 2) + 4 * (i & 1) + (lr & 3));
  return (u32)(16 * i + lr);
}
DI void g2_stage_half(char* smem, const G2Desc& d, int t, int slot, int half) {
  const int lane = fresh_tid() & 63, gsrc = (0x78 >> (2 * ((lane >> 4) & 3))) & 3, pc = ((lane & 3) ^ gsrc) * 8;
  char* base = smem + slot * 24576 + lane * 16;
  if (half == 0) {
#pragma unroll
    for (int i = 0; i < 12; ++i) {
      const int r = 16 * i + (lane >> 2);
      const u32 ro = d.tab ? d.tab[r] : (u32)min(r, d.rmax) * d.lda;
      glds16(d.A + ro + pc + t * 32, base + i * 1024);
    }
  } else {
#pragma unroll
    for (int i = 12; i < 16; ++i) {
      const int r = 16 * i + (lane >> 2);
      const u32 ro = d.tab ? d.tab[r] : (u32)min(r, d.rmax) * d.lda;
      glds16(d.A + ro + pc + t * 32, base + i * 1024);
    }
#pragma unroll
    for (int i = 0; i < 8; ++i) glds16(d.B + g2_brow(d.bperm, i, lane >> 2) * d.ldb + pc + t * 32, base + 16384 + i * 1024);
  }
}
template <int OFF> DI void ldsr(bf16x8& d, u32 a) { asm volatile("ds_read_b128 %0, %1 offset:%2" : "=v"(d) : "v"(a), "n"(OFF)); }
struct G2State { int g, slot; };
DI void g2_begin(char* smem, const G2Desc& d, int nkt, G2State& st) {
  const int wid = __builtin_amdgcn_readfirstlane(fresh_tid() >> 6);
  __syncthreads();
  st.g = 0; st.slot = 0;
  if ((wid >> 1) < nkt) g2_stage_half(smem, d, wid >> 1, wid >> 1, wid & 1);
}
DI void g2_rows(const G2Desc& d, int half, u32 (&ro)[12]) {
  const int lr = (fresh_tid() & 63) >> 2;
  if (half == 0) {
    if (d.tab) {
      const u32 ta = (u32)(uintptr_t)d.tab + (u32)lr * 4u;
      asm volatile("ds_read_b32 %0, %12\n ds_read_b32 %1, %12 offset:64\n ds_read_b32 %2, %12 offset:128\n ds_read_b32 %3, %12 offset:192\n"
                   "ds_read_b32 %4, %12 offset:256\n ds_read_b32 %5, %12 offset:320\n ds_read_b32 %6, %12 offset:384\n ds_read_b32 %7, %12 offset:448\n"
                   "ds_read_b32 %8, %12 offset:512\n ds_read_b32 %9, %12 offset:576\n ds_read_b32 %10, %12 offset:640\n ds_read_b32 %11, %12 offset:704\n"
                   "s_waitcnt lgkmcnt(0)"
                   : "=&v"(ro[0]), "=&v"(ro[1]), "=&v"(ro[2]), "=&v"(ro[3]), "=&v"(ro[4]), "=&v"(ro[5]), "=&v"(ro[6]), "=&v"(ro[7]),
                     "=&v"(ro[8]), "=&v"(ro[9]), "=&v"(ro[10]), "=&v"(ro[11]) : "v"(ta) : "memory");
    } else {
#pragma unroll
      for (int j = 0; j < 12; ++j) ro[j] = (u32)min(16 * j + lr, d.rmax) * d.lda;
    }
  } else {
    if (d.tab) {
      const u32 ta = (u32)(uintptr_t)d.tab + (u32)(192 + lr) * 4u;
      asm volatile("ds_read_b32 %0, %4\n ds_read_b32 %1, %4 offset:64\n ds_read_b32 %2, %4 offset:128\n ds_read_b32 %3, %4 offset:192\n"
                   "s_waitcnt lgkmcnt(0)"
                   : "=&v"(ro[0]), "=&v"(ro[1]), "=&v"(ro[2]), "=&v"(ro[3]) : "v"(ta) : "memory");
    } else {
#pragma unroll
      for (int j = 0; j < 4; ++j) ro[j] = (u32)min(192 + 16 * j + lr, d.rmax) * d.lda;
    }
#pragma unroll
    for (int j = 4; j < 12; ++j) ro[j] = g2_brow(d.bperm, j - 4, lr) * d.ldb;
  }
}
DI void g2_run(char* smem, const G2Desc& d, int nkt, bool has_next, const G2Desc& nx, f32x4 (&acc)[8][4], G2State& st) {
  const int tid = fresh_tid(), lane = tid & 63, wid = __builtin_amdgcn_readfirstlane(tid >> 6), wr = wid >> 1, wc = wid & 1, fr = lane & 15, fq = lane >> 4;
  const int grd = (0x78 >> (2 * ((fr >> 2) & 3))) & 3, rdq = (fq ^ grd) * 16;
  const int half = wid & 1, gsrc = (0x78 >> (2 * ((lane >> 4) & 3))) & 3;
  const u32 pc = (u32)(((lane & 3) ^ gsrc) * 8);
#pragma unroll
  for (int m = 0; m < 8; ++m)
#pragma unroll
    for (int n = 0; n < 4; ++n) acc[m][n] = (f32x4){0.f, 0.f, 0.f, 0.f};
  int g = st.g, slot = st.slot;
  u32 ro[12];
#pragma unroll
  for (int j = 0; j < 12; ++j) ro[j] = 0u;
  if ((wid >> 1) == (g & 1)) g2_rows(d, half, ro);
#pragma unroll 1
  for (int t = 0; t < nkt; ++t) {
    const bool mine = (wid >> 1) == (g & 1);
    if (mine) asm volatile("s_waitcnt vmcnt(0)" ::: "memory");
    asm volatile("s_waitcnt lgkmcnt(0)" ::: "memory");
    __builtin_amdgcn_s_barrier();
    const u32 la = (u32)(uintptr_t)smem + (u32)slot * 24576u + (u32)(fr * 64 + rdq);
    const u32 laB = la + 16384u + (u32)(wc * 4096), laA = la + (u32)(wr * 8192);
    bf16x8 Bt[4], At[8];
    ldsr<0>(Bt[0], laB); ldsr<1024>(Bt[1], laB); ldsr<2048>(Bt[2], laB); ldsr<3072>(Bt[3], laB);
    ldsr<0>(At[0], laA); ldsr<1024>(At[1], laA); ldsr<2048>(At[2], laA); ldsr<3072>(At[3], laA);
    ldsr<4096>(At[4], laA); ldsr<5120>(At[5], laA); ldsr<6144>(At[6], laA); ldsr<7168>(At[7], laA);
    const bool un = t + 2 >= nkt, son = mine && (!un || has_next);
    const int tt = un ? t + 2 - nkt : t + 2, s2 = slot >= 1 ? slot - 1 : 2;
    const u16* Aq = (un ? nx.A : d.A) + (((un ? nx.split : d.split) && tt >= 32) ? tt * 32 - 1024 : tt * 32);
    const u16* Bq = (un ? nx.B : d.B) + tt * 32;
    char* dq = smem + s2 * 24576 + half * 12288 + lane * 16;
#define G2_ISSUE(J) glds16(((half && (J) >= 4) ? Bq : Aq) + ro[J] + pc, dq + (J) * 1024)
#define G2_MMA(M) _Pragma("unroll") for (int n = 0; n < 4; ++n) acc[M][n] = MFMA16(Bt[n], At[M], acc[M][n]);
    __builtin_amdgcn_s_setprio(1);
    __builtin_amdgcn_sched_barrier(0);
    asm volatile("s_waitcnt lgkmcnt(7)" : "+v"(Bt[0]), "+v"(Bt[1]), "+v"(Bt[2]), "+v"(Bt[3]), "+v"(At[0]));
    G2_MMA(0)
    if (son) { G2_ISSUE(0); G2_ISSUE(1); G2_ISSUE(2); }
    __builtin_amdgcn_sched_barrier(0);
    asm volatile("s_waitcnt lgkmcnt(6)" : "+v"(At[1]));
    G2_MMA(1)
    if (son) { G2_ISSUE(3); G2_ISSUE(4); G2_ISSUE(5); }
    __builtin_amdgcn_sched_barrier(0);
    asm volatile("s_waitcnt lgkmcnt(5)" : "+v"(At[2]));
    G2_MMA(2)
    if (son) { G2_ISSUE(6); G2_ISSUE(7); G2_ISSUE(8); }
    __builtin_amdgcn_sched_barrier(0);
    asm volatile("s_waitcnt lgkmcnt(4)" : "+v"(At[3]));
    G2_MMA(3)
    if (son) { G2_ISSUE(9); G2_ISSUE(10); G2_ISSUE(11); }
    __builtin_amdgcn_sched_barrier(0);
    asm volatile("s_waitcnt lgkmcnt(3)" : "+v"(At[4]));
    G2_MMA(4)
    __builtin_amdgcn_sched_barrier(0);
    asm volatile("s_waitcnt lgkmcnt(2)" : "+v"(At[5]));
    G2_MMA(5)
    __builtin_amdgcn_sched_barrier(0);
    asm volatile("s_waitcnt lgkmcnt(1)" : "+v"(At[6]));
    G2_MMA(6)
    __builtin_amdgcn_sched_barrier(0);
    asm volatile("s_waitcnt lgkmcnt(0)" : "+v"(At[7]));
    G2_MMA(7)
    __builtin_amdgcn_sched_barrier(0);
    __builtin_amdgcn_s_setprio(0);
#undef G2_ISSUE
#undef G2_MMA
    if (!mine) {
      const bool un1 = t + 3 >= nkt;
      if (!un1) g2_rows(d, half, ro); else if (has_next && t + 1 < nkt) g2_rows(nx, half, ro);
    }
    ++g; slot = slot == 2 ? 0 : slot + 1;
  }
  st.g = g; st.slot = slot;
}

DI int xcd_item(int bid, int nblk, int k, int total) {
  const int x = bid & 7, v = bid >> 3, nv = nblk >> 3, per = (total + 7) >> 3;
  const int j = v + k * nv;
  if (j >= per) return -1;
  const int it = x * per + j;
  return it < total ? it : -1;
}
struct ARowLin { int ld; DI u32 operator()(int r) const { return (u32)r * (u32)ld; } };

template <int MR>
DI void epi_proj(const Params& p, f32x4 (&acc)[MR][4], int row0, int col0) {
  const int tid = fresh_tid(), lane = tid & 63, wid = tid >> 6, wr = wid >> 1, wc = wid & 1, fr = lane & 15, fq = lane >> 4;
  const int hh = (col0 + wc * 64) >> 6;
  char* ws = p.ws;
  if (hh == 41) {
    if (fq == 0) {
      float* WI = (float*)(ws + O_WI);
#pragma unroll
      for (int m = 0; m < MR; ++m) {
        const int tok = row0 + wr * (MR * 16) + m * 16 + fr;
        const float sc = 0.04419417382415922f;
        *(f32x4*)(WI + tok * 8) = (f32x4){acc[m][0][0] * sc, acc[m][0][1] * sc, acc[m][0][2] * sc, acc[m][0][3] * sc};
        *(f32x4*)(WI + tok * 8 + 4) = (f32x4){acc[m][1][0] * sc, acc[m][1][1] * sc, acc[m][1][2] * sc, acc[m][1][3] * sc};
      }
    }
    return;
  }
  const int kind = (hh < 10 || (hh >= 23 && hh < 35)) ? 2 : (hh < 12 ? 2 : (hh < 14 ? 0 : (hh < 23 ? 1 : 0)));
  const bool kv = hh >= 10 && hh < 14;
  const float oscale = (hh < 10 || (hh >= 23 && hh < 29)) ? 0.125f : 1.f;
  size_t dbase; int dstride, dcol;
  if (hh < 10) { dbase = O_QA; dstride = 640; dcol = hh * 64; }
  else if (hh < 12) { dbase = O_KV; dstride = 128; dcol = 0; }
  else if (hh < 14) { dbase = O_KV; dstride = 128; dcol = 64; }
  else if (hh < 22) { dbase = O_QI; dstride = 512; dcol = (hh - 14) * 64; }
  else if (hh < 23) { dbase = O_KI; dstride = 64; dcol = 0; }
  else if (hh < 29) { dbase = O_QB; dstride = 384; dcol = (hh - 23) * 64; }
  else if (hh < 35) { dbase = O_KB; dstride = 384; dcol = (hh - 29) * 64; }
  else { dbase = O_VB; dstride = 384; dcol = (hh - 35) * 64; }
  u16* dst = (u16*)(ws + dbase);
  const int kvh = kv ? ((hh < 12) ? hh - 10 : hh - 12) : 0;
  f32x4 gn[4];
#pragma unroll
  for (int n = 0; n < 4; ++n) {
    const int c = 32 * (n >> 1) + 8 * fq + 4 * (n & 1);
    const f32x4 ga = *(const f32x4*)(p.qna + c), gb = *(const f32x4*)(p.kna + c);
    const f32x4 gc = *(const f32x4*)(p.qnb + c), gd = *(const f32x4*)(p.knb + c);
    gn[n] = hh < 10 ? ga : hh < 12 ? gb : hh < 29 ? gc : gd;
  }
  const int tok0 = row0 + wr * (MR * 16) + fr;
  const f32x4* rp = (const f32x4*)((const float2*)(ws + O_ROPE) + (size_t)tok0 * 32 + 8 * fq);
  float kss_max = 0.f;
  u32x4 outp[MR][2];
#pragma unroll
  for (int m = 0; m < MR; ++m) {
    f32x4 v[4];
#pragma unroll
    for (int n = 0; n < 4; ++n) v[n] = acc[m][n];
    if (kind == 2) {
      float ss = 0.f;
#pragma unroll
      for (int n = 0; n < 4; ++n)
#pragma unroll
        for (int j = 0; j < 4; ++j) ss = fmaf(v[n][j], v[n][j], ss);
      ss += __shfl_xor(ss, 16); ss += __shfl_xor(ss, 32);
      const float rstd = rsqrtf(ss * (1.f / 64.f) + EPS_);
#pragma unroll
      for (int n = 0; n < 4; ++n)
#pragma unroll
        for (int j = 0; j < 4; ++j) v[n][j] *= rstd * gn[n][j];
    }
    if (kind >= 1) {
#pragma unroll
      for (int n = 0; n < 2; ++n) {
        const f32x4 ca = rp[m * 256 + 2 * n], cb = rp[m * 256 + 2 * n + 1];
        const float cs[4] = {ca[0], ca[2], cb[0], cb[2]}, sn[4] = {ca[1], ca[3], cb[1], cb[3]};
#pragma unroll
        for (int j = 0; j < 4; ++j) {
          const float t1 = v[n][j], t2 = v[n + 2][j];
          v[n][j] = t1 * cs[j] - t2 * sn[j]; v[n + 2][j] = t2 * cs[j] + t1 * sn[j];
        }
      }
    }
    float kss = 0.f;
#pragma unroll
    for (int h = 0; h < 2; ++h) {
      const u32x4 pk = {pack2(v[2 * h][0] * oscale, v[2 * h][1] * oscale), pack2(v[2 * h][2] * oscale, v[2 * h][3] * oscale),
                        pack2(v[2 * h + 1][0] * oscale, v[2 * h + 1][1] * oscale), pack2(v[2 * h + 1][2] * oscale, v[2 * h + 1][3] * oscale)};
      outp[m][h] = pk;
      if (hh == 22) {
#pragma unroll
        for (int e = 0; e < 4; ++e) { const float a0 = __uint_as_float(pk[e] << 16), a1 = __uint_as_float(pk[e] & 0xffff0000u); kss += a0 * a0 + a1 * a1; }
      }
    }
    if (hh == 22) { kss += __shfl_xor(kss, 16); kss += __shfl_xor(kss, 32); kss_max = fmaxf(kss_max, kss); }
  }
#pragma unroll
  for (int m = 0; m < MR; ++m) {
    const int tok = tok0 + m * 16;
    size_t rowoff;
    if (kv) { const int b = tok >> 13, s_ = tok & 8191; rowoff = ((size_t)(b * 2 + kvh) * 8192 + s_) * 128; }
    else rowoff = (size_t)tok * dstride;
#pragma unroll
    for (int h = 0; h < 2; ++h) *(u32x4*)(dst + rowoff + dcol + 32 * h + 8 * fq) = outp[m][h];
  }
  if (hh == 22) {
#pragma unroll
    for (int o = 1; o < 16; o <<= 1) kss_max = fmaxf(kss_max, __shfl_xor(kss_max, o));
    if (lane == 0) atomicMax((u32*)(ws + O_KMAX) + (row0 >> 13), __float_as_uint(kss_max));
  }
}

__device__ __forceinline__ void phase_proj(const Params& p, char* smem, int bid, int nblk) {
  const u16* H = (const u16*)(p.ws + O_H);
  const u16* W = (const u16*)(p.ws + O_WT_IN);
  auto mk = [&](int it) { G2Desc d; d.bperm = 0; d.split = 0; d.A = H + (size_t)(it / 21) * 256 * 2048; d.B = W + (size_t)(it % 21) * 128 * 1024; d.lda = 2048; d.ldb = 1024; d.rmax = 255; d.tab = nullptr; d.bperm = 2; return d; };
  int k = 0, it = xcd_item(bid, nblk, 0, 128 * 21);
  if (it < 0) return;
  G2Desc dc = mk(it); G2State st;
  g2_begin(smem, dc, 32, st);
  while (true) {
    const int itn = xcd_item(bid, nblk, ++k, 128 * 21);
    G2Desc dn = dc; if (itn >= 0) dn = mk(itn);
    f32x4 acc[8][4];
    g2_run(smem, dc, 32, itn >= 0, dn, acc, st);
    epi_proj<8>(p, acc, (it / 21) * 256, (it % 21) * 128);
    if (itn < 0) break;
    it = itn; dc = dn;
  }
}

__device__ __forceinline__ void phase_outproj(const Params& p, char* smem, int bid, int nblk) {
  const int tid = fresh_tid(), lane = tid & 63, wid = tid >> 6, wr = wid >> 1, wc = wid & 1, fr = lane & 15, fq = lane >> 4;
  const u16* A = (const u16*)(p.ws + O_O);
  const u16* W = (const u16*)(p.ws + O_WT_OUT);
  const float* mod = (const float*)(p.ws + O_MOD);
  auto mk = [&](int it) { G2Desc d; d.bperm = 0; d.split = 0; d.A = A + (size_t)(it >> 3) * 256 * 1024; d.B = W + (size_t)(it & 7) * 128 * 1024; d.lda = 1024; d.ldb = 1024; d.rmax = 255; d.tab = nullptr; d.bperm = 1; return d; };
  int k = 0, it = xcd_item(bid, nblk, 0, 128 * 8);
  if (it < 0) return;
  G2Desc dc = mk(it); G2State st;
  g2_begin(smem, dc, 32, st);
  while (true) {
    const int itn = xcd_item(bid, nblk, ++k, 128 * 8);
    G2Desc dn = dc; if (itn >= 0) dn = mk(itn);
    f32x4 acc[8][4];
    g2_run(smem, dc, 32, itn >= 0, dn, acc, st);
    const int row0 = (it >> 3) * 256, col0 = (it & 7) * 128, b = row0 >> 13;
    const float* xp = p.x + (size_t)(row0 + wr * 128 + fr) * 1024 + col0 + wc * 64 + 16 * fq;
    u16* op = (u16*)(p.ws + O_X1) + (size_t)(row0 + wr * 128 + fr) * 1024 + col0 + wc * 64 + 16 * fq;
    const float* gp = mod + b * 6144 + 2 * 1024 + col0 + wc * 64 + 16 * fq;
    f32x4 gt[4];
#pragma unroll
    for (int n = 0; n < 4; ++n) gt[n] = *(const f32x4*)(gp + 4 * n);
#pragma unroll
    for (int mp = 0; mp < 4; ++mp) {
      f32x4 xv[2][4];
#pragma unroll
      for (int mm = 0; mm < 2; ++mm)
#pragma unroll
        for (int n = 0; n < 4; ++n) xv[mm][n] = *(const f32x4*)(xp + (2 * mp + mm) * 16384 + 4 * n);
#pragma unroll
      for (int mm = 0; mm < 2; ++mm) {
        const int m = 2 * mp + mm;
#pragma unroll
        for (int h = 0; h < 2; ++h) {
          const f32x4 a = xv[mm][2 * h] + gt[2 * h] * acc[m][2 * h], c = xv[mm][2 * h + 1] + gt[2 * h + 1] * acc[m][2 * h + 1];
          *(u32x4*)(op + m * 16384 + 8 * h) = (u32x4){pack2(a[0], a[1]), pack2(a[2], a[3]), pack2(c[0], c[1]), pack2(c[2], c[3])};
        }
      }
    }
    if (itn < 0) break;
    it = itn; dc = dn;
  }
}

__device__ __forceinline__ void phase_router_sgu(const Params& p, char* smem, int bid, int nblk) {
  const int tid = fresh_tid(), lane = tid & 63, wid = tid >> 6, wr = wid >> 1, wc = wid & 1, fr = lane & 15, fq = lane >> 4;
  const u16* H = (const u16*)(p.ws + O_H);
  if (nblk == 512) {
    const int x = bid & 7, v = bid >> 3;
    if (v < 32) {
      const int rt = x * 32 + v;
      G2Desc d; d.bperm = 0; d.split = 1; d.A = H + (size_t)(rt >> 1) * 256 * 2048; d.B = (const u16*)(p.ws + O_WT_RT) + (size_t)(rt & 1) * 128 * 3072;
      d.lda = 2048; d.ldb = 3072; d.rmax = 255; d.tab = nullptr;
      G2State st;
      g2_begin(smem, d, 96, st);
      f32x4 acc[8][4];
      g2_run(smem, d, 96, false, d, acc, st);
      float* L = (float*)(p.ws + O_LOGITS) + (size_t)((rt >> 1) * 256 + wr * 128 + fr) * 256 + (rt & 1) * 128 + wc * 64 + 4 * fq;
#pragma unroll
      for (int m = 0; m < 8; ++m)
#pragma unroll
        for (int n = 0; n < 4; ++n) *(f32x4*)(L + m * 16 * 256 + n * 16) = acc[m][n];
    } else {
      const u16* W = (const u16*)(p.ws + O_WT_SGU);
      u16* AS = (u16*)(p.ws + O_ACTS);
      auto mk = [&](int it) { G2Desc d; d.bperm = 2; d.split = 0; d.A = H + (size_t)(it >> 2) * 256 * 2048; d.B = W + (size_t)(it & 3) * 128 * 1024; d.lda = 2048; d.ldb = 1024; d.rmax = 255; d.tab = nullptr; return d; };
      const int st0 = x * 64 + (v - 32) * 2;
      G2Desc dc = mk(st0), dn = mk(st0 + 1); G2State st;
      g2_begin(smem, dc, 32, st);
#pragma unroll 1
      for (int r = 0; r < 2; ++r) {
        const int it = st0 + r;
        f32x4 acc[8][4];
        g2_run(smem, r == 0 ? dc : dn, 32, r == 0, dn, acc, st);
        const int row0 = (it >> 2) * 256, acol0 = ((it & 3) * 128 + wc * 64) >> 1;
#pragma unroll
        for (int m = 0; m < 8; ++m) {
          const f32x4 g0 = acc[m][0], g1 = acc[m][1], u0 = acc[m][2], u1 = acc[m][3];
          const u32x4 pk = {pack2(silu_f(g0[0]) * u0[0], silu_f(g0[1]) * u0[1]), pack2(silu_f(g0[2]) * u0[2], silu_f(g0[3]) * u0[3]),
                            pack2(silu_f(g1[0]) * u1[0], silu_f(g1[1]) * u1[1]), pack2(silu_f(g1[2]) * u1[2], silu_f(g1[3]) * u1[3])};
          *(u32x4*)(AS + (size_t)(row0 + wr * 128 + m * 16 + fr) * 256 + acol0 + 8 * fq) = pk;
        }
      }
    }
    return;
  }
  {
    const u16* W = (const u16*)(p.ws + O_WT_RT);
    float* L = (float*)(p.ws + O_LOGITS);
    int k = 0, it = xcd_item(bid, nblk, 0, 512);
    if (it >= 0) {
      GDesc dc = g_make(H + (size_t)(it >> 1) * 128 * 2048, ARowLin{2048}, W + (size_t)(it & 1) * 128 * 3072, 3072, 1);
      g_begin(smem, dc, 96);
      while (true) {
        const int itn = xcd_item(bid, nblk, ++k, 512);
        GDesc dn = dc;
        if (itn >= 0) dn = g_make(H + (size_t)(itn >> 1) * 128 * 2048, ARowLin{2048}, W + (size_t)(itn & 1) * 128 * 3072, 3072, 1);
        f32x4 acc[4][4];
        g_run(smem, dc, 96, itn >= 0, dn, acc);
        const int row0 = (it >> 1) * 128, col0 = (it & 1) * 128;
#pragma unroll
        for (int m = 0; m < 4; ++m)
#pragma unroll
          for (int n = 0; n < 4; ++n)
            *(f32x4*)(L + (size_t)(row0 + wr * 64 + m * 16 + fr) * 256 + col0 + wc * 64 + n * 16 + 4 * fq) = acc[m][n];
        if (itn < 0) break;
        it = itn; dc = dn;
      }
    }
  }
  {
    const u16* W = (const u16*)(p.ws + O_WT_SGU);
    u16* AS = (u16*)(p.ws + O_ACTS);
    auto mk = [&](int it) { G2Desc d; d.bperm = 2; d.split = 0; d.A = H + (size_t)(it >> 2) * 256 * 2048; d.B = W + (size_t)(it & 3) * 128 * 1024; d.lda = 2048; d.ldb = 1024; d.rmax = 255; d.tab = nullptr; return d; };
    int k = 0, it = xcd_item(bid, nblk, 0, 512);
    if (it >= 0) {
      G2Desc dc = mk(it); G2State st;
      g2_begin(smem, dc, 32, st);
      while (true) {
        const int itn = xcd_item(bid, nblk, ++k, 512);
        G2Desc dn = dc; if (itn >= 0) dn = mk(itn);
        f32x4 acc[8][4];
        g2_run(smem, dc, 32, itn >= 0, dn, acc, st);
        const int row0 = (it >> 2) * 256, acol0 = ((it & 3) * 128 + wc * 64) >> 1;
#pragma unroll
        for (int m = 0; m < 8; ++m) {
          const f32x4 g0 = acc[m][0], g1 = acc[m][1], u0 = acc[m][2], u1 = acc[m][3];
          const u32x4 pk = {pack2(silu_f(g0[0]) * u0[0], silu_f(g0[1]) * u0[1]), pack2(silu_f(g0[2]) * u0[2], silu_f(g0[3]) * u0[3]),
                            pack2(silu_f(g1[0]) * u1[0], silu_f(g1[1]) * u1[1]), pack2(silu_f(g1[2]) * u1[2], silu_f(g1[3]) * u1[3])};
          *(u32x4*)(AS + (size_t)(row0 + wr * 128 + m * 16 + fr) * 256 + acol0 + 8 * fq) = pk;
        }
        if (itn < 0) break;
        it = itn; dc = dn;
      }
    }
  }
}

DI void route_token(const Params& p, int tok) {
  const int lane = fresh_tid() & 63;
  const float4 lg = *(const float4*)((const float*)(p.ws + O_LOGITS) + (size_t)tok * 256 + lane * 4);
  const float4 bs = *(const float4*)(p.rbias + lane * 4);
  float sc[4] = {sigmoid_f(lg.x), sigmoid_f(lg.y), sigmoid_f(lg.z), sigmoid_f(lg.w)};
  float bi[4] = {sc[0] + bs.x, sc[1] + bs.y, sc[2] + bs.z, sc[3] + bs.w};
  float t1 = fmaxf(bi[0], bi[1]), t2 = fminf(bi[0], bi[1]);
  { float a = fmaxf(bi[2], bi[3]), b = fminf(bi[2], bi[3]);
    float n1 = fmaxf(t1, a), n2 = fmaxf(fminf(t1, a), fmaxf(t2, b)); t1 = n1; t2 = n2; }
#pragma unroll
  for (int o = 1; o < 8; o <<= 1) {
    float a = __shfl_xor(t1, o), b = __shfl_xor(t2, o);
    float n1 = fmaxf(t1, a), n2 = fmaxf(fminf(t1, a), fmaxf(t2, b)); t1 = n1; t2 = n2;
  }
  const float gs = t1 + t2;
  const int g = lane >> 3;
  int rank = 0;
#pragma unroll
  for (int gg = 0; gg < 8; ++gg) { const float o = __shfl(gs, gg * 8); rank += (o > gs || (o == gs && gg < g)) ? 1 : 0; }
  const bool allowed = rank < 4;
  float cand[4];
#pragma unroll
  for (int e = 0; e < 4; ++e) cand[e] = allowed ? bi[e] : -INFINITY;
  int sel[8]; float gsel[8]; float gsum = 0.f;
#pragma unroll
  for (int k = 0; k < 8; ++k) {
    float bv = cand[0]; int be = 0;
#pragma unroll
    for (int e = 1; e < 4; ++e) if (cand[e] > bv) { bv = cand[e]; be = e; }
    int bidx = lane * 4 + be;
#pragma unroll
    for (int o = 1; o < 64; o <<= 1) {
      const float ov = __shfl_xor(bv, o); const int oi = __shfl_xor(bidx, o);
      if (ov > bv || (ov == bv && oi < bidx)) { bv = ov; bidx = oi; }
    }
    sel[k] = bidx;
    const int ol = bidx >> 2, oe = bidx & 3;
    float sv = (oe == 0) ? sc[0] : (oe == 1) ? sc[1] : (oe == 2) ? sc[2] : sc[3];
    sv = __shfl(sv, ol);
    gsel[k] = sv; gsum += sv;
    if (lane == ol) {
#pragma unroll
      for (int e = 0; e < 4; ++e) if (e == oe) cand[e] = -INFINITY;
    }
  }
  if (lane < 8) {
    int e = sel[0]; float gv = gsel[0];
#pragma unroll
    for (int k = 1; k < 8; ++k) if (lane == k) { e = sel[k]; gv = gsel[k]; }
    const int pos = atomicAdd((int*)(p.ws + O_CNT) + e, 1);
    ((int*)(p.ws + O_SELE))[tok * 8 + lane] = e;
    ((float*)(p.ws + O_GATE))[tok * 8 + lane] = gv / gsum * 2.5f;
    ((int*)(p.ws + O_POSE))[tok * 8 + lane] = pos;
  }
}

__device__ __forceinline__ void phase_route_sdown(const Params& p, char* smem, int bid, int nblk) {
  const int tid = fresh_tid(), lane = tid & 63, wid = tid >> 6, wr = wid >> 1, wc = wid & 1, fr = lane & 15, fq = lane >> 4;
  for (int it = bid; it < NTOK / 64; it += nblk)
    for (int i = 0; i < 16; ++i) route_token(p, it * 64 + wid * 16 + i);
  const u16* A = (const u16*)(p.ws + O_ACTS);
  const u16* W = (const u16*)(p.ws + O_WT_SD);
  unsigned char* Y9 = (unsigned char*)(p.ws + O_Y9);
  auto mk = [&](int it) { G2Desc d; d.bperm = 1; d.split = 0; d.A = A + (size_t)(it >> 3) * 256 * 256; d.B = W + (size_t)(it & 7) * 128 * 256; d.lda = 256; d.ldb = 256; d.rmax = 255; d.tab = nullptr; return d; };
  int k = 0, it = xcd_item(bid, nblk, 0, 128 * 8);
  if (it < 0) return;
  G2Desc dc = mk(it); G2State st;
  g2_begin(smem, dc, 8, st);
  while (true) {
    const int itn = xcd_item(bid, nblk, ++k, 128 * 8);
    G2Desc dn = dc; if (itn >= 0) dn = mk(itn);
    f32x4 acc[8][4];
    g2_run(smem, dc, 8, itn >= 0, dn, acc, st);
    const int row0 = (it >> 3) * 256, col0 = (it & 7) * 128;
#pragma unroll
    for (int m = 0; m < 8; ++m) {
      u32x4 pk;
#pragma unroll
      for (int n = 0; n < 4; ++n) pk[n] = pack4_fp8(acc[m][n] * YSCALE);
      __builtin_nontemporal_store(pk, (u32x4*)(Y9 + (size_t)(row0 + wr * 128 + m * 16 + fr) * 1024 + col0 + wc * 64 + 16 * fq));
    }
    if (itn < 0) break;
    it = itn; dc = dn;
  }
}

DI void expert_tables(const Params& p, int* off, int* toff, int tshift = 7) {
  const int tid = fresh_tid();
  __syncthreads();
  const int cnt = ((const int*)(p.ws + O_CNT))[tid];
  off[tid + 1] = cnt; toff[tid + 1] = (cnt + (1 << tshift) - 1) >> tshift;
  if (tid == 0) { off[0] = 0; toff[0] = 0; }
  __syncthreads();
  if (tid < 64) {
    int a[4], b[4]; int sa = 0, sb = 0;
#pragma unroll
    for (int i = 0; i < 4; ++i) { sa += off[1 + tid * 4 + i]; a[i] = sa; sb += toff[1 + tid * 4 + i]; b[i] = sb; }
    int pa = sa, pb = sb;
#pragma unroll
    for (int o = 1; o < 64; o <<= 1) { int ta = __shfl_up(pa, o), tb = __shfl_up(pb, o); if (tid >= o) { pa += ta; pb += tb; } }
    pa -= sa; pb -= sb;
#pragma unroll
    for (int i = 0; i < 4; ++i) { off[1 + tid * 4 + i] = pa + a[i]; toff[1 + tid * 4 + i] = pb + b[i]; }
  }
  __syncthreads();
}
DI int find_expert(const int* toff, int tile) {
  int lo = 0, hi = 255;
  while (lo < hi) { int mid = (lo + hi + 1) >> 1; if (toff[mid] <= tile) lo = mid; else hi = mid - 1; }
  return lo;
}

__device__ __forceinline__ void phase_dispatch(const Params& p, char* smem, int bid, int nblk) {
  int* off = (int*)(smem + 73728); int* toff = off + 260;
  expert_tables(p, off, toff);
  const int* sele = (const int*)(p.ws + O_SELE); const int* pose = (const int*)(p.ws + O_POSE);
  const float* gate = (const float*)(p.ws + O_GATE);
  int* tokslot = (int*)(p.ws + O_TOKSLOT); int* slottok = (int*)(p.ws + O_SLOTTOK); float* slotgate = (float*)(p.ws + O_SLOTGATE);
  for (int i = bid * THREADS + fresh_tid(); i < NSLOT; i += nblk * THREADS) {
    const int slot = off[sele[i]] + pose[i];
    tokslot[i] = slot; slottok[slot] = i >> 3; slotgate[slot] = gate[i];
  }
}

struct MoeItem { int e, s0, send, col0; };
DI MoeItem moe_item(const int* off, const int* toff, int it, int nshift) {
  const int tile = it >> nshift, nt = it & ((1 << nshift) - 1), e = find_expert(toff, tile);
  MoeItem m; m.e = e; m.s0 = off[e] + (tile - toff[e]) * 256; m.send = off[e + 1]; m.col0 = nt * 128;
  return m;
}
__device__ __forceinline__ void phase_moe_up(const Params& p, char* smem, int bid, int nblk) {
  const int tid = fresh_tid(), lane = tid & 63, wid = tid >> 6, wr = wid >> 1, wc = wid & 1, fr = lane & 15, fq = lane >> 4;
  int* off = (int*)(smem + 73728); int* toff = off + 260;
  u32* gtab = (u32*)(smem + 73728 + 2560);
  float* gate_t = (float*)(smem + 73728 + 2560 + 2048);
  expert_tables(p, off, toff, 8);
  const int total = toff[256] * 4;
  const u16* H = (const u16*)(p.ws + O_H);
  const int* slottok = (const int*)(p.ws + O_SLOTTOK);
  const float* slotgate = (const float*)(p.ws + O_SLOTGATE);
  u16* ACT = (u16*)(p.ws + O_ACT);
  auto mk = [&](const MoeItem& m, int par) {
    const int sl = m.s0 + tid;
    gtab[par * 256 + tid] = (u32)(sl < m.send ? slottok[sl] : 0) * 2048u;
    gate_t[par * 256 + tid] = sl < m.send ? slotgate[sl] : 0.f;
    G2Desc d; d.bperm = 0; d.split = 0; d.A = H; d.B = (const u16*)(p.ws + O_WT_EGU) + (size_t)m.e * 512 * 1024 + (size_t)m.col0 * 1024; d.lda = 0; d.ldb = 1024; d.rmax = 255; d.tab = gtab + par * 256; d.bperm = 2;
    return d;
  };
  int k = 0, it = xcd_item(bid, nblk, 0, total), par = 0;
  if (it < 0) return;
  MoeItem cur = moe_item(off, toff, it, 2);
  G2Desc dc = mk(cur, par); G2State st;
  g2_begin(smem, dc, 32, st);
  while (true) {
    const int itn = xcd_item(bid, nblk, ++k, total);
    MoeItem nxi = cur; G2Desc dn = dc;
    if (itn >= 0) { nxi = moe_item(off, toff, itn, 2); dn = mk(nxi, par ^ 1); }
    float gw[8];
#pragma unroll
    for (int m = 0; m < 8; ++m) gw[m] = gate_t[par * 256 + wr * 128 + m * 16 + fr];
    f32x4 acc[8][4];
    g2_run(smem, dc, 32, itn >= 0, dn, acc, st);
    const int acol0 = (cur.col0 + wc * 64) >> 1;
#pragma unroll
    for (int m = 0; m < 8; ++m) {
      const int slot = cur.s0 + wr * 128 + m * 16 + fr;
      if (slot < cur.send) {
        const f32x4 g0 = acc[m][0], g1 = acc[m][1], u0 = gw[m] * acc[m][2], u1 = gw[m] * acc[m][3];
        const u32x4 pk = {pack2(silu_f(g0[0]) * u0[0], silu_f(g0[1]) * u0[1]), pack2(silu_f(g0[2]) * u0[2], silu_f(g0[3]) * u0[3]),
                          pack2(silu_f(g1[0]) * u1[0], silu_f(g1[1]) * u1[1]), pack2(silu_f(g1[2]) * u1[2], silu_f(g1[3]) * u1[3])};
        *(u32x4*)(ACT + (size_t)slot * 256 + acol0 + 8 * fq) = pk;
      }
    }
    if (itn < 0) break;
    cur = nxi; dc = dn; par ^= 1;
  }
}

__device__ __forceinline__ void phase_moe_down(const Params& p, char* smem, int bid, int nblk) {
  const int tid = fresh_tid(), lane = tid & 63, wid = tid >> 6, wr = wid >> 1, wc = wid & 1, fr = lane & 15, fq = lane >> 4;
  int* off = (int*)(smem + 73728); int* toff = off + 260;
  expert_tables(p, off, toff, 8);
  const int total = toff[256] * 8;
  const u16* ACT = (const u16*)(p.ws + O_ACT);
  unsigned char* Y = (unsigned char*)(p.ws + O_BIG);
  auto mk = [&](const MoeItem& m) {
    G2Desc d; d.bperm = 0; d.split = 0; d.A = ACT + (size_t)m.s0 * 256; d.B = (const u16*)(p.ws + O_WT_ED) + (size_t)m.e * 1024 * 256 + (size_t)m.col0 * 256;
    d.lda = 256; d.ldb = 256; d.rmax = min(255, NSLOT - 1 - m.s0); d.tab = nullptr; d.bperm = 1;
    return d;
  };
  int k = 0, it = xcd_item(bid, nblk, 0, total);
  if (it < 0) return;
  MoeItem cur = moe_item(off, toff, it, 3);
  G2Desc dc = mk(cur); G2State st;
  g2_begin(smem, dc, 8, st);
  while (true) {
    const int itn = xcd_item(bid, nblk, ++k, total);
    MoeItem nxi = cur; G2Desc dn = dc;
    if (itn >= 0) { nxi = moe_item(off, toff, itn, 3); dn = mk(nxi); }
    f32x4 acc[8][4];
    g2_run(smem, dc, 8, itn >= 0, dn, acc, st);
#pragma unroll
    for (int m = 0; m < 8; ++m) {
      const int slot = cur.s0 + wr * 128 + m * 16 + fr;
      if (slot < cur.send) {
        u32x4 pk;
#pragma unroll
        for (int n = 0; n < 4; ++n) pk[n] = pack4_fp8(acc[m][n] * YSCALE);
        *(u32x4*)(Y + (size_t)slot * 1024 + cur.col0 + wc * 64 + 16 * fq) = pk;
      }
    }
    if (itn < 0) break;
    cur = nxi; dc = dn;
  }
}

__device__ __forceinline__ void phase_combine(const Params& p, int bid, int nblk) {
  const int lane = fresh_tid() & 63, wid = fresh_tid() >> 6;
  const unsigned char* Y = (const unsigned char*)(p.ws + O_BIG);
  const int* tokslot = (const int*)(p.ws + O_TOKSLOT);
  const float* mod = (const float*)(p.ws + O_MOD);
  for (int it = bid; it < NTOK / 4; it += nblk) {
    const int tok = it * 4 + wid, b = tok >> 13, col = lane * 16;
    int sl[8];
#pragma unroll
    for (int k = 0; k < 8; ++k) sl[k] = tokslot[tok * 8 + k];
    float* o = p.out + (size_t)tok * 1024 + col;
    const float* g = mod + b * 6144 + 5 * 1024 + col;
    f32x4 ov[4], gv[4];
    const u32x4 x0 = *(const u32x4*)((const u16*)(p.ws + O_X1) + (size_t)tok * 1024 + col), x1 = *(const u32x4*)((const u16*)(p.ws + O_X1) + (size_t)tok * 1024 + col + 8);
#pragma unroll
    for (int e = 0; e < 4; ++e) gv[e] = *(const f32x4*)(g + 4 * e);
    u32x4 yv[9];
#pragma unroll
    for (int k = 0; k < 8; ++k) yv[k] = *(const u32x4*)(Y + (size_t)sl[k] * 1024 + col);
    yv[8] = *(const u32x4*)((const unsigned char*)(p.ws + O_Y9) + (size_t)tok * 1024 + col);
#pragma unroll
    for (int e = 0; e < 2; ++e) {
      ov[e] = (f32x4){__uint_as_float(x0[2 * e] << 16), __uint_as_float(x0[2 * e] & 0xffff0000u), __uint_as_float(x0[2 * e + 1] << 16), __uint_as_float(x0[2 * e + 1] & 0xffff0000u)};
      ov[e + 2] = (f32x4){__uint_as_float(x1[2 * e] << 16), __uint_as_float(x1[2 * e] & 0xffff0000u), __uint_as_float(x1[2 * e + 1] << 16), __uint_as_float(x1[2 * e + 1] & 0xffff0000u)};
    }
    f32x4 a[4] = {};
#pragma unroll
    for (int k = 0; k < 9; ++k)
#pragma unroll
      for (int e = 0; e < 4; ++e) {
        const f32x2 lo = __builtin_amdgcn_cvt_pk_f32_fp8((int)yv[k][e], false), hi = __builtin_amdgcn_cvt_pk_f32_fp8((int)yv[k][e], true);
        a[e][0] += lo[0]; a[e][1] += lo[1]; a[e][2] += hi[0]; a[e][3] += hi[1];
      }
#pragma unroll
    for (int e = 0; e < 4; ++e) *(f32x4*)(o + 4 * e) = ov[e] + gv[e] * (a[e] * (1.f / YSCALE));
  }
}

constexpr int IDX_NB = 256, IDX_CB = 128;
constexpr int IX_A = 32768;
constexpr int IX_W = 65536, IX_SCALE = IX_W + 1024, IX_OFF = IX_SCALE + 128, IX_THR = IX_OFF + 128, IX_ABOVE = IX_THR + 128,
              IX_CIN = IX_ABOVE + 128, IX_LCS = IX_CIN + 128, IX_UCS = IX_LCS + 128, IX_FLAG = IX_UCS + 128, IX_DUMMY = IX_FLAG + 16,
              IX_LIST = IX_DUMMY + 16, IX_LIST_STRIDE = 256 + 1024, IX_END = IX_LIST + 4 * IX_LIST_STRIDE;
static_assert(IX_END <= SMEM_BYTES, "indexer LDS");
constexpr size_t O_BINS = O_O;
constexpr size_t BINS_PER_BATCH = (size_t)1024 * (256 * 257 / 2);
static_assert(O_BINS + 4 * BINS_PER_BATCH <= O_ACT, "bin image does not fit");

DI u32 mono_f32(float f) { const u32 u = __float_as_uint(f); return (u >> 31) ? ~u : (u | 0x80000000u); }

template <bool CHECK>
DI void emit_step(const u32 (&w4)[4], int k0, int n, int tc, int& base, int& na, u16* selrow, u16* ambk, int lane) {
#pragma unroll
  for (int u = 0; u < 4; ++u) {
    const int kk = k0 + u * 256 + lane * 4;
#pragma unroll
    for (int j = 0; j < 4; ++j) {
      const int key = kk + j, cb = (int)((w4[u] >> (8 * j)) & 255u);
      bool ab = cb > tc, am = cb == tc;
      if (CHECK) { const bool valid = key < n; ab = ab && valid; am = am && valid; }
      const unsigned long long mA = __ballot(ab), mB = __ballot(am);
      if (ab) { const int pos = base + (int)__builtin_amdgcn_mbcnt_hi((u32)(mA >> 32), __builtin_amdgcn_mbcnt_lo((u32)mA, 0u)); selrow[min(pos, NSEL - 1)] = (u16)key; }
      if (am) { const int pos = na + (int)__builtin_amdgcn_mbcnt_hi((u32)(mB >> 32), __builtin_amdgcn_mbcnt_lo((u32)mB, 0u)); if (pos < IDX_CB) ambk[pos] = (u16)key; }
      base += __popcll(mA); na += __popcll(mB);
    }
  }
}

__device__ __forceinline__ void indexer_item(const Params& p, char* smem, int b, int qb) {
  const int tid = fresh_tid(), lane = tid & 63, wid = tid >> 6, hl = lane >> 5;
  const int q0 = qb * 32, tok0 = b * S_ + q0, KW = (qb + 1) * 32;
  const u16* QI = (const u16*)(p.ws + O_QI);
  const u16* KI = (const u16*)(p.ws + O_KI) + (size_t)b * S_ * 64;
  const float* WI = (const float*)(p.ws + O_WI);
  u16* SEL = (u16*)(p.ws + O_SEL);
  int* SELCNT = (int*)(p.ws + O_SELCNT);
  unsigned char* BINS = (unsigned char*)(p.ws + O_BINS) + (size_t)b * BINS_PER_BATCH + (size_t)1024 * (qb * (qb + 1) / 2);
  float* w_lds = (float*)(smem + IX_W);
  float* sc_lds = (float*)(smem + IX_SCALE); float* of_lds = (float*)(smem + IX_OFF);
  float* lcs_lds = (float*)(smem + IX_LCS); float* ucs_lds = (float*)(smem + IX_UCS);
  int* thr_lds = (int*)(smem + IX_THR); int* above_lds = (int*)(smem + IX_ABOVE); int* cin_lds = (int*)(smem + IX_CIN);
  int* flag_lds = (int*)(smem + IX_FLAG);
  u32* hist = (u32*)smem;
  __syncthreads();
  {
    const int q = tid >> 3, h = tid & 7;
    const u16* qr = QI + (size_t)(tok0 + q) * 512 + h * 64;
    float ss = 0.f;
#pragma unroll
    for (int i = 0; i < 8; ++i) { const u32x4 v = *(const u32x4*)(qr + i * 8);
      *(u32x4*)(smem + IX_A + tid * 128 + ((i ^ ((tid >> 1) & 7)) * 16)) = v;
#pragma unroll
      for (int e = 0; e < 4; ++e) { float a = __uint_as_float(v[e] << 16), c = __uint_as_float(v[e] & 0xffff0000u); ss += a * a + c * c; } }
    const float kmax = sqrtf(__uint_as_float(((const u32*)(p.ws + O_KMAX))[b]));
    const float nrm = sqrtf(ss) * kmax, w = WI[(tok0 + q) * 8 + h];
    w_lds[q * 8 + h] = 0.5f * w;
    float ps = w > 0.f ? w * nrm : 0.f, ns = w < 0.f ? -w * nrm : 0.f;
    float mu = w * nrm * (0.3989423f * 0.125f), var = w * w * nrm * nrm * (0.3408f / 64.f);
#pragma unroll
    for (int o = 1; o < 8; o <<= 1) { ps += __shfl_xor(ps, o); ns += __shfl_xor(ns, o); mu += __shfl_xor(mu, o); var += __shfl_xor(var, o); }
    float U = ps, L = -ns; const float span = U - L;
    U += span * 1e-3f + 1e-30f; L -= span * 1e-3f + 1e-30f;
    const float sd = sqrtf(var);
    const float pq = fminf(256.f / (float)(q0 + q + 1), 0.999f), pt = pq > 0.5f ? 1.f - pq : pq;
    const float tt_ = sqrtf(-2.f * __logf(pt));
    float zq = tt_ - (2.515517f + 0.802853f * tt_ + 0.010328f * tt_ * tt_) / (1.f + 1.432788f * tt_ + 0.189269f * tt_ * tt_ + 0.001308f * tt_ * tt_ * tt_);
    zq = pq > 0.5f ? -zq : zq;
    const float lo = fmaxf(L, mu + (zq - 3.5f) * sd), hi = fminf(U, mu + (zq + 3.5f) * sd);
    const float scale = (float)(IDX_NB - 2) / fmaxf(hi - lo, 1e-30f);
    if (h == 0) { sc_lds[q] = scale; of_lds[q] = 1.f - lo * scale; lcs_lds[q] = L; ucs_lds[q] = U;
                  thr_lds[q] = -1; above_lds[q] = 0; cin_lds[q] = 0; }
    if (tid == 0) flag_lds[0] = 0;
  }
  for (int i = tid; i < 32768 / 16; i += THREADS) ((u32x4*)smem)[i] = (u32x4){0u, 0u, 0u, 0u};
  int aoff[4];
  { const int r = lane & 31, tq = 2 * ((r >> 2) & 1) + (r >> 4), h = (r & 3) + 4 * ((r >> 3) & 1), rowg = tq * 8 + h;
#pragma unroll
    for (int ks = 0; ks < 4; ++ks) aoff[ks] = IX_A + rowg * 128 + (((2 * ks + hl) ^ ((rowg >> 1) & 7)) * 16); }
  __syncthreads();
  const int nchunk = (qb + 4) >> 2;
  int iter = 0;
  bool again = (q0 + 32) > NSEL;
  while (again) {
    for (int ch = wid; ch < nchunk; ch += 4) {
      bf16x8 Bf[4][4];
#pragma unroll
      for (int tt = 0; tt < 4; ++tt) {
        const int keyl = min((ch * 4 + tt) * 32 + (lane & 31), S_ - 1);
#pragma unroll
        for (int ks = 0; ks < 4; ++ks) Bf[tt][ks] = *(const bf16x8*)(KI + (size_t)keyl * 64 + ks * 16 + 8 * hl);
      }
#pragma unroll 1
      for (int rt = 0; rt < 8; ++rt) {
        bf16x8 Af[4];
#pragma unroll
        for (int ks = 0; ks < 4; ++ks) Af[ks] = *(const bf16x8*)(smem + aoff[ks] + rt * 4096);
        const int qa = rt * 4 + 2 * hl;
        const f32x4 wa0 = *(const f32x4*)(w_lds + qa * 8), wa1 = *(const f32x4*)(w_lds + qa * 8 + 4);
        const f32x4 wb0 = *(const f32x4*)(w_lds + qa * 8 + 8), wb1 = *(const f32x4*)(w_lds + qa * 8 + 12);
        const float sca = sc_lds[qa], scb = sc_lds[qa + 1], ofa = of_lds[qa], ofb = of_lds[qa + 1];
#pragma unroll
        for (int tp = 0; tp < 2; ++tp) {
          f32x16 acc[2];
          __builtin_amdgcn_s_setprio(1);
#pragma unroll
          for (int t2 = 0; t2 < 2; ++t2) {
#pragma unroll
            for (int i = 0; i < 16; ++i) acc[t2][i] = 0.f;
#pragma unroll
            for (int ks = 0; ks < 4; ++ks) acc[t2] = MFMA32(Af[ks], Bf[tp * 2 + t2][ks], acc[t2]);
          }
          __builtin_amdgcn_s_setprio(0);
#pragma unroll
          for (int t2 = 0; t2 < 2; ++t2) {
            const int kt = ch * 4 + tp * 2 + t2;
            if (kt <= qb) {
              const int key = kt * 32 + (lane & 31);
#pragma unroll
              for (int u = 0; u < 2; ++u) {
                const int q = qa + u;
                const f32x4 w0 = u ? wb0 : wa0, w1 = u ? wb1 : wa1;
                float s1 = 0.f, s2 = 0.f;
#pragma unroll
                for (int h = 0; h < 4; ++h) { const float x = acc[t2][8 * u + h]; s1 = fmaf(w0[h], x, s1); s2 = fmaf(w0[h], __builtin_fabsf(x), s2); }
#pragma unroll
                for (int h = 0; h < 4; ++h) {
                  const float x = acc[t2][8 * u + 4 + h], wv = w1[h];
                  asm("v_fmac_f32 %0, %1, %2" : "+v"(s1) : "v"(wv), "v"(x));
                  asm("v_fma_f32 %0, %1, |%2|, %0" : "+v"(s2) : "v"(wv), "v"(x));
                }
                const float s = s1 + s2;
                int bin = (int)fmaf(s, u ? scb : sca, u ? ofb : ofa);
                bin = min(max(bin, 0), IDX_NB - 1);
                const bool valid = key <= q0 + q;
                atomicAdd((u32*)(smem + (valid ? (q * IDX_NB + bin) * 4 : IX_DUMMY)), 1u);
                BINS[(u32)(q * KW + key)] = (unsigned char)bin;
              }
            }
          }
        }
      }
    }
    __syncthreads();
    for (int qq = 0; qq < 8; ++qq) {
      const int q = wid * 8 + qq;
      const u32x4 wv = *(const u32x4*)(hist + q * IDX_NB + lane * 4);
      const int local = (int)(wv[0] + wv[1] + wv[2] + wv[3]);
      int suf = local;
#pragma unroll
      for (int o = 1; o < 64; o <<= 1) { const int t = __shfl_down(suf, o); if (lane + o < 64) suf += t; }
      if (suf >= NSEL && suf - local < NSEL) {
        int cum = suf - local, bt = 0, ab = 0, cin = 0; bool found = false;
#pragma unroll
        for (int i = 3; i >= 0; --i) {
          const int c = (int)wv[i];
          if (!found) { if (cum + c >= NSEL) { found = true; bt = lane * 4 + i; ab = cum; cin = c; } else cum += c; }
        }
        thr_lds[q] = bt; above_lds[q] = ab; cin_lds[q] = cin;
        if (cin > IDX_CB) flag_lds[0] = 1;
      }
    }
    __syncthreads();
    again = flag_lds[0] != 0 && iter < 3;
    __syncthreads();
    if (again) {
      if (tid < 32 && cin_lds[tid] > IDX_CB) {
        const int q = tid, bt = thr_lds[q];
        const float sc = sc_lds[q], of = of_lds[q], inv = 1.f / sc;
        float lo = ((float)bt - of) * inv, hi = ((float)(bt + 1) - of) * inv;
        if (bt == 0) lo = lcs_lds[q];
        if (bt == IDX_NB - 1) hi = ucs_lds[q];
        const float wdt = hi - lo; lo -= 0.02f * wdt; hi += 0.02f * wdt;
        const float nsc = (float)(IDX_NB - 2) / (hi - lo);
        if (nsc < 1e30f && nsc > sc) { sc_lds[q] = nsc; of_lds[q] = 1.f - lo * nsc; }
      }
      if (tid == 0) flag_lds[0] = 0;
      ++iter;
      for (int i = tid; i < 32768 / 16; i += THREADS) ((u32x4*)smem)[i] = (u32x4){0u, 0u, 0u, 0u};
      __syncthreads();
    }
  }
  asm volatile("s_waitcnt vmcnt(0)" ::: "memory");
  __syncthreads();
  u16* ambk = (u16*)(smem + IX_LIST + wid * IX_LIST_STRIDE);
  u64* comp = (u64*)(smem + IX_LIST + wid * IX_LIST_STRIDE + 256);
  const unsigned long long lt_mask = (1ull << lane) - 1ull;
  for (int qq = 0; qq < 8; ++qq) {
    const int q = wid * 8 + qq, tok = tok0 + q, n = q0 + q + 1;
    u16* selrow = SEL + (size_t)tok * NSEL;
    int total;
    if (n <= NSEL) {
      for (int i = lane; i < n; i += 64) selrow[i] = (u16)i;
      total = n;
    } else {
      const int tc = thr_lds[q];
      const unsigned char* row = BINS + (size_t)q * KW;
      int base = 0, na = 0;
      u32 w4[4];
#pragma unroll
      for (int u = 0; u < 4; ++u) w4[u] = __builtin_nontemporal_load((const u32*)(row + (u32)(lane * 4)) + u * 64);
#pragma unroll 1
      for (int k0 = 0; k0 < n; k0 += 1024) {
        u32 wn[4] = {0u, 0u, 0u, 0u};
        if (k0 + 1024 < n) {
#pragma unroll
          for (int u = 0; u < 4; ++u) wn[u] = __builtin_nontemporal_load((const u32*)(row + (u32)(k0 + 1024 + lane * 4)) + u * 64);
        }
        if (k0 + 1024 <= n) emit_step<false>(w4, k0, n, tc, base, na, selrow, ambk, lane);
        else emit_step<true>(w4, k0, n, tc, base, na, selrow, ambk, lane);
#pragma unroll
        for (int u = 0; u < 4; ++u) w4[u] = wn[u];
      }
      base = min(base, NSEL); na = min(na, IDX_CB);
      const int r = NSEL - base;
      {
        const int i16 = lane & 15, G = lane >> 4, rowg = q * 8 + (i16 & 7);
        bf16x8 Aq[2];
#pragma unroll
        for (int ks = 0; ks < 2; ++ks) Aq[ks] = *(const bf16x8*)(smem + IX_A + rowg * 128 + (((4 * ks + G) ^ ((rowg >> 1) & 7)) * 16));
        const f32x4 wq = *(const f32x4*)(w_lds + q * 8 + 4 * (G & 1));
#pragma unroll 1
        for (int t0 = 0; t0 < na; t0 += 16) {
          const int e = t0 + i16, key = e < na ? (int)ambk[e] : 0;
          const u16* kr = KI + (size_t)key * 64 + 8 * G;
          const bf16x8 B0 = *(const bf16x8*)kr, B1 = *(const bf16x8*)(kr + 32);
          f32x4 c = {0.f, 0.f, 0.f, 0.f};
          c = MFMA16(Aq[0], B0, c); c = MFMA16(Aq[1], B1, c);
          float part = 0.f;
#pragma unroll
          for (int j = 0; j < 4; ++j) part = fmaf(wq[j], c[j] + __builtin_fabsf(c[j]), part);
          part += __shfl_xor(part, 16);
          if (G == 0 && e < na) comp[e] = ((u64)mono_f32(part) << 16) | (u64)(0xFFFF - key);
        }
      }
#pragma unroll 1
      for (int half = 0; half < 2; ++half) {
        const int e = lane + 64 * half;
        const u64 my = e < na ? comp[e] : 0ull;
        int rank = 0;
#pragma unroll 8
        for (int j = 0; j < na; ++j) rank += (comp[j] > my) ? 1 : 0;
        if (e < na && rank < r) selrow[base + rank] = (u16)(0xFFFF - (int)(my & 0xFFFF));
      }
      total = base + min(r, na);
    }
    if (lane == 0) SELCNT[tok] = total;
  }
}

__device__ __forceinline__ void phase_indexer(const Params& p, char* smem, int bid, int nblk) {
  for (int it = bid; it < 1024; it += nblk) {
    const int b = it & 3, j = (it & 511) >> 2, qb = it < 512 ? j : 255 - j;
    indexer_item(p, smem, b, qb);
  }
}

__device__ __forceinline__ void dilated_item(const Params& p, char* smem, int item) {
  const int tid = fresh_tid(), lane = tid & 63, wid = tid >> 6, hl = lane >> 5, ql = lane & 31, i16 = lane & 15;
  const int br = item / 1536, rem = item % 1536, b = rem / 384, h = (rem % 384) >> 6, blk = rem & 63;
  const int lg = 2 * br, dil = 1 << lg, nper = 64 >> lg, r = blk / nper, n = blk % nper;
  const u16* QB = (const u16*)(p.ws + O_QB) + (size_t)b * S_ * 384 + h * 64;
  const u16* KB = (const u16*)(p.ws + O_KB) + (size_t)b * S_ * 384 + h * 64;
  const u16* VB = (const u16*)(p.ws + O_VB) + (size_t)b * S_ * 384 + h * 64;
  __syncthreads();
  u32x4 vst[8];
#pragma unroll
  for (int jj = 0; jj < 8; ++jj) {
    const int piece = tid + 256 * jj, row = piece >> 3, c = piece & 7, mk = 128 * (n - 1) + row;
    vst[jj] = *(const u32x4*)(VB + (size_t)(max(mk, 0) * dil + r) * 384 + c * 8);
  }
#pragma unroll
  for (int jj = 0; jj < 8; ++jj) {
    const int piece = tid + 256 * jj, row = piece >> 3, c = piece & 7, mk = 128 * (n - 1) + row;
    *(u32x4*)(smem + row * 128 + ((c ^ (((row >> 1) & 1) << 2)) * 16)) = mk >= 0 ? vst[jj] : (u32x4){0u, 0u, 0u, 0u};
  }
  __syncthreads();
  const int mq0 = 128 * n + 32 * wid;
  bf16x8 Qf[4];
#pragma unroll
  for (int ks = 0; ks < 4; ++ks) Qf[ks] = *(const bf16x8*)(QB + (size_t)((mq0 + ql) * dil + r) * 384 + ks * 16 + 8 * hl);
  f32x16 S[5];
#pragma unroll
  for (int i = 0; i < 5; ++i) {
    const int mk = max(mq0 - 128 + 32 * i + ql, 0);
    const u16* kr = KB + (size_t)(mk * dil + r) * 384 + 8 * hl;
#pragma unroll
    for (int e = 0; e < 16; ++e) S[i][e] = 0.f;
#pragma unroll
    for (int ks = 0; ks < 4; ++ks) S[i] = MFMA32(*(const bf16x8*)(kr + ks * 16), Qf[ks], S[i]);
  }
  float mx = -1e30f;
#pragma unroll
  for (int i = 0; i < 5; ++i)
#pragma unroll
    for (int e = 0; e < 16; ++e) {
      const int cr = (e & 3) + 8 * (e >> 2) + 4 * hl;
      const int key = mq0 - 128 + 32 * i + cr, mq = mq0 + ql;
      const bool valid = key >= 0 && key <= mq && key >= mq - 128;
      S[i][e] = valid ? S[i][e] : -1e30f;
      mx = fmaxf(mx, S[i][e]);
    }
  mx = fmaxf(mx, __shfl_xor(mx, 32));
  float ls = 0.f;
#pragma unroll
  for (int i = 0; i < 5; ++i)
#pragma unroll
    for (int e = 0; e < 16; ++e) { const float pv = __expf(S[i][e] - mx); S[i][e] = pv; ls += pv; }
  ls += __shfl_xor(ls, 32);
  f32x16 O[2];
#pragma unroll
  for (int dt = 0; dt < 2; ++dt)
#pragma unroll
    for (int e = 0; e < 16; ++e) O[dt][e] = 0.f;
#pragma unroll
  for (int i = 0; i < 5; ++i)
#pragma unroll
    for (int s = 0; s < 2; ++s) {
      const bf16x8 Pf = pack8(S[i][8 * s], S[i][8 * s + 1], S[i][8 * s + 2], S[i][8 * s + 3], S[i][8 * s + 4], S[i][8 * s + 5], S[i][8 * s + 6], S[i][8 * s + 7]);
#pragma unroll
      for (int dt = 0; dt < 2; ++dt) {
        const int row1 = 32 * wid + 32 * i + 16 * s + 4 * hl + (i16 >> 2), row2 = row1 + 8;
        const int c = 4 * dt + 2 * ((lane >> 4) & 1) + ((i16 & 3) >> 1), by = 8 * (i16 & 1);
        const s16x4 lo = tr_read(smem + row1 * 128 + ((c ^ (((row1 >> 1) & 1) << 2)) * 16) + by);
        const s16x4 hi = tr_read(smem + row2 * 128 + ((c ^ (((row2 >> 1) & 1) << 2)) * 16) + by);
        const bf16x8 Vf = __builtin_shufflevector(lo, hi, 0, 1, 2, 3, 4, 5, 6, 7);
        O[dt] = MFMA32(Pf, Vf, O[dt]);
      }
    }
  u16* DN = (u16*)(p.ws + O_DNUM2) + ((size_t)br * NTOK + (size_t)b * S_) * 384 + h * 64;
  float* DM = (float*)(p.ws + O_DML2) + ((size_t)br * NTOK + (size_t)b * S_) * 12 + h * 2;
#pragma unroll
  for (int dt = 0; dt < 2; ++dt)
#pragma unroll
    for (int e = 0; e < 16; ++e) {
      const int cr = (e & 3) + 8 * (e >> 2) + 4 * hl, s = (mq0 + cr) * dil + r;
      DN[(size_t)s * 384 + dt * 32 + ql] = f2bf(O[dt][e]);
    }
  if (hl == 0) { const int s = (mq0 + ql) * dil + r; DM[(size_t)s * 12] = mx; DM[(size_t)s * 12 + 1] = ls; }
}
__device__ __forceinline__ void phase_dilated(const Params& p, char* smem, int bid, int nblk) {
  for (int it = bid; it < 4608; it += nblk) dilated_item(p, smem, it);
}
__device__ __forceinline__ void phase_dil_combine(const Params& p, int bid, int nblk) {
  const u16* DN = (const u16*)(p.ws + O_DNUM2); const float* DM = (const float*)(p.ws + O_DML2);
  u16* O = (u16*)(p.ws + O_O);
  for (int i = bid * THREADS + fresh_tid(); i < NTOK * 6 * 8; i += nblk * THREADS) {
    const int tok = i / 48, rem = i % 48, h = rem >> 3, d0 = (rem & 7) * 8;
    float m[3], l[3];
#pragma unroll
    for (int br = 0; br < 3; ++br) { m[br] = DM[((size_t)br * NTOK + tok) * 12 + h * 2]; l[br] = DM[((size_t)br * NTOK + tok) * 12 + h * 2 + 1]; }
    const float mm = fmaxf(m[0], fmaxf(m[1], m[2]));
    float w[3], den = 0.f;
#pragma unroll
    for (int br = 0; br < 3; ++br) { w[br] = __expf(m[br] - mm); den += w[br] * l[br]; }
    const float inv = 1.f / den;
    float a[8] = {0.f, 0.f, 0.f, 0.f, 0.f, 0.f, 0.f, 0.f};
#pragma unroll
    for (int br = 0; br < 3; ++br) {
      const u32x4 v = *(const u32x4*)(DN + ((size_t)br * NTOK + tok) * 384 + h * 64 + d0);
#pragma unroll
      for (int e = 0; e < 4; ++e) { a[2 * e] += w[br] * __uint_as_float(v[e] << 16); a[2 * e + 1] += w[br] * __uint_as_float(v[e] & 0xffff0000u); }
    }
    u32x4 o = {pack2(a[0] * inv, a[1] * inv), pack2(a[2] * inv, a[3] * inv), pack2(a[4] * inv, a[5] * inv), pack2(a[6] * inv, a[7] * inv)};
    *(u32x4*)(O + (size_t)tok * 1024 + 640 + h * 64 + d0) = o;
  }
}

__device__ __forceinline__ void sparse_item(const Params& p, char* wbase, int b, int kvh, int q, int (&kraw)[16], int& cnt_io, bool has_next, int qn) {
  const int lane = fresh_tid() & 63, g = lane & 15, G = lane >> 4, i16 = g;
  const int tok = b * S_ + q;
  const u16* QA = (const u16*)(p.ws + O_QA) + (size_t)tok * 640 + kvh * 320;
  const u16* KV = (const u16*)(p.ws + O_KV) + (size_t)(b * 2 + kvh) * S_ * 128;
  const int cnt = cnt_io;
  bf16x8 Qf[2];
#pragma unroll
  for (int ks = 0; ks < 2; ++ks) {
    Qf[ks] = (bf16x8){0, 0, 0, 0, 0, 0, 0, 0};
    if (g < 5) Qf[ks] = *(const bf16x8*)(QA + g * 64 + ks * 32 + 8 * G);
  }
  int keys[16];
#pragma unroll
  for (int i = 0; i < 16; ++i) keys[i] = (16 * i + g) < cnt ? kraw[i] : 0;
  u32x4 vpre[8];
  auto vload = [&](int ci) {
#pragma unroll
    for (int ii = 0; ii < 8; ++ii) {
      const int key = __shfl(keys[4 * ci + (ii >> 1)], 8 * (ii & 1) + (lane >> 3));
      vpre[ii] = *(const u32x4*)(KV + (size_t)key * 128 + 64 + (lane & 7) * 8);
    }
  };
  vload(0);
  f32x4 S[16];
#pragma unroll
  for (int bb = 0; bb < 2; ++bb) {
    bf16x8 ka[8], kb[8];
#pragma unroll
    for (int i = 0; i < 8; ++i) {
      const u16* kr = KV + (size_t)keys[8 * bb + i] * 128 + 8 * G;
      ka[i] = *(const bf16x8*)kr; kb[i] = *(const bf16x8*)(kr + 32);
    }
#pragma unroll
    for (int i = 0; i < 8; ++i) {
      S[8 * bb + i] = (f32x4){0.f, 0.f, 0.f, 0.f};
      S[8 * bb + i] = MFMA16(ka[i], Qf[0], S[8 * bb + i]);
      S[8 * bb + i] = MFMA16(kb[i], Qf[1], S[8 * bb + i]);
    }
    __builtin_amdgcn_sched_barrier(0);
  }
  if (has_next) {
    const u16* seln = (const u16*)(p.ws + O_SEL) + (size_t)(b * S_ + qn) * NSEL;
#pragma unroll
    for (int i = 0; i < 16; ++i) kraw[i] = (int)seln[16 * i + g];
    cnt_io = ((const int*)(p.ws + O_SELCNT))[b * S_ + qn];
  }
  float mx = -1e30f;
#pragma unroll
  for (int i = 0; i < 16; ++i)
#pragma unroll
    for (int e = 0; e < 4; ++e) { const bool valid = (16 * i + 4 * G + e) < cnt; S[i][e] = valid ? S[i][e] : -1e30f; mx = fmaxf(mx, S[i][e]); }
  mx = fmaxf(mx, __shfl_xor(mx, 16)); mx = fmaxf(mx, __shfl_xor(mx, 32));
  float ls = 0.f;
#pragma unroll
  for (int i = 0; i < 16; ++i)
#pragma unroll
    for (int e = 0; e < 4; ++e) { const float pv = __expf(S[i][e] - mx); S[i][e] = pv; ls += pv; }
  ls += __shfl_xor(ls, 16); ls += __shfl_xor(ls, 32);
  f32x4 O[4];
#pragma unroll
  for (int nt = 0; nt < 4; ++nt) O[nt] = (f32x4){0.f, 0.f, 0.f, 0.f};
#pragma unroll
  for (int ci = 0; ci < 4; ++ci) {
#pragma unroll
    for (int ii = 0; ii < 8; ++ii) {
      const int row = 8 * ii + (lane >> 3), c = lane & 7;
      *(u32x4*)(wbase + row * 128 + ((c ^ (((row >> 1) & 3) << 1)) * 16)) = vpre[ii];
    }
    if (ci < 3) vload(ci + 1);
#pragma unroll
    for (int i2 = 0; i2 < 2; ++i2) {
      const int t0 = 4 * ci + 2 * i2;
      const bf16x8 Pf = pack8(S[t0][0], S[t0][1], S[t0][2], S[t0][3], S[t0 + 1][0], S[t0 + 1][1], S[t0 + 1][2], S[t0 + 1][3]);
#pragma unroll
      for (int nt = 0; nt < 4; ++nt) {
        const int row1 = 32 * i2 + 4 * G + (i16 >> 2), row2 = row1 + 16;
        const int c = 2 * nt + ((i16 & 3) >> 1), by = 8 * (i16 & 1);
        const s16x4 lo = tr_read(wbase + row1 * 128 + ((c ^ (((row1 >> 1) & 3) << 1)) * 16) + by);
        const s16x4 hi = tr_read(wbase + row2 * 128 + ((c ^ (((row2 >> 1) & 3) << 1)) * 16) + by);
        const bf16x8 Vf = __builtin_shufflevector(lo, hi, 0, 1, 2, 3, 4, 5, 6, 7);
        O[nt] = MFMA16(Vf, Pf, O[nt]);
      }
    }
  }
  u16* Oo = (u16*)(p.ws + O_O) + (size_t)tok * 1024 + kvh * 320;
  if (g < 5) {
    const float inv = 1.f / ls;
#pragma unroll
    for (int nt = 0; nt < 4; ++nt) {
      const u32x2 pk = {pack2(O[nt][0] * inv, O[nt][1] * inv), pack2(O[nt][2] * inv, O[nt][3] * inv)};
      *(u32x2*)(Oo + g * 64 + nt * 16 + 4 * G) = pk;
    }
  }
}
__device__ __forceinline__ void phase_sparse(const Params& p, char* smem, int bid, int nblk) {
  const int tid = fresh_tid(), wid = tid >> 6, g = tid & 15;
  char* wbase = smem + wid * 8192;
  const bool aff = (nblk & 7) == 0;
  const int grp = bid & 7, j = bid >> 3, nj = nblk >> 3;
  int it = aff ? j * 4 + wid : bid * 4 + wid;
  const int step = aff ? nj * 4 : nblk * 4, lim = aff ? S_ : NTOK * 2;
  auto dec = [&](int i, int& b, int& kvh, int& q) { if (aff) { b = grp >> 1; kvh = grp & 1; q = i; } else { b = i >> 14; kvh = (i >> 13) & 1; q = i & 8191; } };
  if (it >= lim) return;
  int b, kvh, q; dec(it, b, kvh, q);
  int kraw[16];
  { const u16* sel = (const u16*)(p.ws + O_SEL) + (size_t)(b * S_ + q) * NSEL;
#pragma unroll
    for (int i = 0; i < 16; ++i) kraw[i] = (int)sel[16 * i + g]; }
  int cnt = ((const int*)(p.ws + O_SELCNT))[b * S_ + q];
  while (true) {
    const int itn = it + step; const bool hn = itn < lim;
    int bn = b, kvhn = kvh, qn = q; if (hn) dec(itn, bn, kvhn, qn);
    sparse_item(p, wbase, b, kvh, q, kraw, cnt, hn && bn == b, qn);
    if (!hn) break;
    if (bn != b) {
      const u16* sel = (const u16*)(p.ws + O_SEL) + (size_t)(bn * S_ + qn) * NSEL;
#pragma unroll
      for (int i = 0; i < 16; ++i) kraw[i] = (int)sel[16 * i + g];
      cnt = ((const int*)(p.ws + O_SELCNT))[bn * S_ + qn];
    }
    it = itn; b = bn; kvh = kvhn; q = qn;
  }
}

#define PHASE_KERNEL(name, body) \
  __global__ void __launch_bounds__(THREADS, 2) name(Params p) { \
    __shared__ __attribute__((aligned(16))) char smem[SMEM_BYTES]; \
    const int bid = blockIdx.x, nblk = gridDim.x; (void)smem; (void)bid; (void)nblk; body; }

PHASE_KERNEL(k_prep, (phase_prep(p, smem, bid, nblk, false), phase_prep(p, smem, bid, nblk, true)))
PHASE_KERNEL(k_norm1, phase_norm(p, p.x, nullptr, p.g_mix, 0, 1, false, bid, nblk))
PHASE_KERNEL(k_proj, phase_proj(p, smem, bid, nblk))
PHASE_KERNEL(k_indexer, phase_indexer(p, smem, bid, nblk))
PHASE_KERNEL(k_dilated, phase_dilated(p, smem, bid, nblk))
PHASE_KERNEL(k_sparse, phase_sparse(p, smem, bid, nblk))
PHASE_KERNEL(k_dilcomb, phase_dil_combine(p, bid, nblk))
PHASE_KERNEL(k_outproj, phase_outproj(p, smem, bid, nblk))
PHASE_KERNEL(k_norm2, phase_norm(p, nullptr, (const u16*)(p.ws + O_X1), p.g_ffn, 3, 4, true, bid, nblk))
PHASE_KERNEL(k_router, phase_router_sgu(p, smem, bid, nblk))
PHASE_KERNEL(k_route, phase_route_sdown(p, smem, bid, nblk))
PHASE_KERNEL(k_dispatch, phase_dispatch(p, smem, bid, nblk))
PHASE_KERNEL(k_moeup, phase_moe_up(p, smem, bid, nblk))
PHASE_KERNEL(k_moedown, phase_moe_down(p, smem, bid, nblk))
PHASE_KERNEL(k_combine, phase_combine(p, bid, nblk))

#if DEBUG_MODE == 1
__device__ float dbg_enc(float x, float base) { return base * (1.f + 9.f * fminf(1.f, log2f(1.f + x) / 20.f)); }
__global__ void k_debug_emit(Params p) {
  const u32* d = (const u32*)(p.ws + O_DBG);
  const float v1 = dbg_enc((float)d[DBG_X1], 1e6f), v2 = dbg_enc((float)d[DBG_X2], 1e5f);
  for (int i = blockIdx.x * blockDim.x + fresh_tid(); i <= 1000000; i += gridDim.x * blockDim.x) p.out[i] = i == 0 ? v1 : v2;
}
#endif

#define XB_TMO      128
#define XB_XCNT(j)  (256  + 64 * (j))
#define XB_XSUB(j)  (1280 + 64 * (j))
#define XB_XGEN(j)  (2304 + 64 * (j))
#define XB_TOP      3328
#define XB_TOPGEN   3392
#define XB_SPIN_CAP (1u << 22)
DI u32 xb_ld(u32* p) { return __hip_atomic_load(p, __ATOMIC_RELAXED, __HIP_MEMORY_SCOPE_AGENT); }
DI u32 xb_add(u32* p, u32 v) { return __hip_atomic_fetch_add(p, v, __ATOMIC_RELAXED, __HIP_MEMORY_SCOPE_AGENT); }
DI u32 xb_xcc_id() { return (u32)__builtin_amdgcn_s_getreg((3 << 11) | 20) & 0xFu; }
#define XB_SPIN(cond, bar) do { u32 _sp = 0; while (cond) { __builtin_amdgcn_s_sleep(1); \
    if ((++_sp & 255u) == 0u) { if (xb_ld(&(bar)[XB_TMO])) break; if (_sp > XB_SPIN_CAP) { atomicAdd(&(bar)[XB_TMO], 1u); break; } } } } while (0)
struct XcdBarrier { u32* bar; u32 x; volatile LDS_AS u32* st; };
DI XcdBarrier xcd_barrier_post(u32* bar, volatile LDS_AS u32* st) {
  XcdBarrier b; b.bar = bar; b.x = xb_xcc_id(); b.st = st;
  if (threadIdx.x == 0) (void)xb_add(&bar[XB_XCNT(b.x)], 1u);
  return b;
}
DI void xcd_barrier_complete(u32* bar, u32 x, u32& nloc, u32& nx) {
  const u32 G = gridDim.x;
  u32 sum, cnt, mine, sp = 0u;
  for (;;) {
    sum = 0u; cnt = 0u; mine = 0u;
#pragma unroll
    for (u32 j = 0; j < 16; ++j) { const u32 c = xb_ld(&bar[XB_XCNT(j)]); sum += c; cnt += (c > 0u) ? 1u : 0u; mine = (j == x) ? c : mine; }
    if (sum == G) break;
    __builtin_amdgcn_s_sleep(1);
    if ((++sp & 255u) == 0u) { if (xb_ld(&bar[XB_TMO])) break; if (sp > XB_SPIN_CAP) { atomicAdd(&bar[XB_TMO], 1u); break; } }
  }
  nloc = mine > 0u ? mine : 1u; nx = cnt > 0u ? cnt : 1u;
}
DI void xcd_barrier(const XcdBarrier& b) {
  asm volatile("s_waitcnt vmcnt(0)" ::: "memory");
  __syncthreads();
  if (threadIdx.x == 0) {
    u32* bar = b.bar;
    __builtin_amdgcn_s_waitcnt(0);
    u32 nloc = b.st[0], nx = b.st[1];
    if (nloc == 0u) { xcd_barrier_complete(bar, b.x, nloc, nx); b.st[0] = nloc; b.st[1] = nx; }
    const u32 old = xb_add(&bar[XB_XSUB(b.x)], 1u);
    const u32 gen = old / nloc;
    if (old + 1u == (gen + 1u) * nloc) {
      __builtin_amdgcn_fence(__ATOMIC_RELEASE, "agent");
      asm volatile("s_waitcnt vmcnt(0)" ::: "memory");
      const u32 og = xb_add(&bar[XB_TOP], 1u);
      const u32 tg = og / nx;
      if (og + 1u == (tg + 1u) * nx) xb_add(&bar[XB_TOPGEN], 1u);
      else XB_SPIN(xb_ld(&bar[XB_TOPGEN]) == tg, bar);
      __builtin_amdgcn_fence(__ATOMIC_ACQUIRE, "agent");
      xb_add(&bar[XB_XGEN(b.x)], 1u);
      asm volatile("s_waitcnt vmcnt(0)" ::: "memory");
    } else {
      XB_SPIN(xb_ld(&bar[XB_XGEN(b.x)]) == gen, bar);
      __builtin_amdgcn_fence(__ATOMIC_ACQUIRE, "agent");
      asm volatile("s_waitcnt vmcnt(0)" ::: "memory");
    }
  }
  __syncthreads();
}

__global__ void __launch_bounds__(THREADS, 2) k_mega(Params p) {
  __shared__ __attribute__((aligned(16))) char smem[SMEM_BYTES + 16];
  cg::grid_group grid = cg::this_grid();
  const int bid = blockIdx.x, nblk = gridDim.x;
  volatile LDS_AS u32* st = (volatile LDS_AS u32*)(smem + SMEM_BYTES);
  if (threadIdx.x == 0) { st[0] = 0u; st[1] = 0u; }
  __syncthreads();
  const XcdBarrier xb = xcd_barrier_post((u32*)(p.ws + O_BAR), st);
  phase_prep(p, smem, bid, nblk, false, 1);
  grid.sync();
  if (bid & 1) { phase_norm(p, p.x, nullptr, p.g_mix, 0, 1, false, bid, nblk); phase_prep(p, smem, bid, nblk, false, 2); }
  else { phase_prep(p, smem, bid, nblk, false, 2); phase_norm(p, p.x, nullptr, p.g_mix, 0, 1, false, bid, nblk); }
  xcd_barrier(xb);
  phase_proj(p, smem, bid, nblk);
  xcd_barrier(xb);
  phase_indexer(p, smem, bid, nblk);
  phase_dilated(p, smem, bid, nblk);
  xcd_barrier(xb);
  phase_sparse(p, smem, bid, nblk);
  phase_dil_combine(p, bid, nblk);
  xcd_barrier(xb);
  phase_outproj(p, smem, bid, nblk);
  xcd_barrier(xb);
  phase_norm(p, nullptr, (const u16*)(p.ws + O_X1), p.g_ffn, 3, 4, true, bid, nblk);
  xcd_barrier(xb);
  phase_router_sgu(p, smem, bid, nblk);
  xcd_barrier(xb);
  if (((bid >> 8) ^ bid) & 1) { phase_conv_experts(p, smem, bid, nblk); phase_route_sdown(p, smem, bid, nblk); }
  else { phase_route_sdown(p, smem, bid, nblk); phase_conv_experts(p, smem, bid, nblk); }
  xcd_barrier(xb);
  phase_dispatch(p, smem, bid, nblk);
  xcd_barrier(xb);
  phase_moe_up(p, smem, bid, nblk);
  xcd_barrier(xb);
  phase_moe_down(p, smem, bid, nblk);
  xcd_barrier(xb);
  phase_combine(p, bid, nblk);
}
#if DEBUG_MODE == 2
__global__ void k_debug_copy(Params p) {
  for (size_t i = blockIdx.x * (size_t)blockDim.x + fresh_tid(); i < (size_t)NTOK * 1024; i += (size_t)gridDim.x * blockDim.x) {
#if DBG_BUF == 0
    p.out[i] = ((i & 1023) >= 640) ? bf2f(((const u16*)(p.ws + O_O))[i]) : 0.f;
#elif DBG_BUF == 4
    { const size_t t = i >> 10; const int c = (int)(i & 1023);
      p.out[i] = c < 384 ? bf2f(((const u16*)(p.ws + O_QB))[t * 384 + c]) : c < 768 ? bf2f(((const u16*)(p.ws + O_KB))[t * 384 + c - 384]) : bf2f(((const u16*)(p.ws + O_VB))[t * 384 + c - 768]); }
#elif DBG_BUF == 8
    { const size_t t = i >> 10; const int c = (int)(i & 1023);
      p.out[i] = c < 384 ? bf2f(((const u16*)(p.ws + O_QB))[t * 384 + c]) : c < 768 ? bf2f(((const u16*)(p.ws + O_KB))[t * 384 + c - 384]) : 0.f; }
#elif DBG_BUF == 5
    { const size_t t = i >> 10; const int c = (int)(i & 1023);
      p.out[i] = c < 384 ? bf2f(((const u16*)(p.ws + O_DNUM))[t * 384 + c]) : c < 768 ? bf2f(((const u16*)(p.ws + O_DNUM))[((size_t)NTOK + t) * 384 + c - 384]) : c < 780 ? ((const float*)(p.ws + O_DML))[t * 12 + c - 768] : 0.f; }
#elif DBG_BUF == 6
    p.out[i] = bf2f(((const u16*)(p.ws + O_H))[(i >> 10) * 2048 + (i & 1023)]);
#elif DBG_BUF == 7
    {
      if (i < 2097152) p.out[i] = ((const float*)(p.ws + O_ROPE))[i];
      else p.out[i] = 0.f; }
#elif DBG_BUF == 1
    p.out[i] = (float)((const u16*)(p.ws + O_SEL))[i % ((size_t)NTOK * 256)];
#elif DBG_BUF == 2
    p.out[i] = bf2f(((const u16*)(p.ws + O_H))[(i >> 10) * 2048 + (i & 1023)]);
#elif DBG_BUF == 3
    p.out[i] = ((const float*)(p.ws + O_LOGITS))[i % ((size_t)NTOK * 256)];
#endif
  }
}
#endif

#if DEBUG_MODE == 3
__global__ void k_check_kb(Params p) {
  const int lane = fresh_tid() & 63, wid = fresh_tid() >> 6;
  const u16* H = (const u16*)(p.ws + O_H); const u16* W = (const u16*)(p.ws + O_WT_IN);
  const u16* KB = (const u16*)(p.ws + O_KB); const float2* rope = (const float2*)(p.ws + O_ROPE);
  u32* dbg = (u32*)(p.ws + O_DBG);
  for (int row = blockIdx.x * 4 + wid; row < NTOK * 6; row += gridDim.x * 4) {
    const int tok = row / 6, hd = row % 6;
    const u16* hr = H + (size_t)tok * 2048; const u16* wr = W + (size_t)(1856 + hd * 64 + lane) * 1024;
    float a = 0.f;
    for (int k = 0; k < 1024; k += 8) {
      const u32x4 hv = *(const u32x4*)(hr + k), wv = *(const u32x4*)(wr + k);
#pragma unroll
      for (int e = 0; e < 4; ++e) { a += __uint_as_float(hv[e] << 16) * __uint_as_float(wv[e] << 16); a += __uint_as_float(hv[e] & 0xffff0000u) * __uint_as_float(wv[e] & 0xffff0000u); }
    }
    const float ss = wave_sum(a * a);
    float v = a * rsqrtf(ss * (1.f / 64.f) + EPS_) * p.knb[lane];
    const float o = __shfl_xor(v, 32);
    const float2 cs = rope[tok * 32 + (lane & 31)];
    v = lane < 32 ? v * cs.x - o * cs.y : v * cs.x + o * cs.y;
    const float got = bf2f(KB[(size_t)tok * 384 + hd * 64 + lane]);
    const bool bad = fabsf(got - v) > 0.03f + 0.02f * fabsf(v);
    const unsigned long long m = __ballot(bad);
    if (m && lane == 0) { atomicAdd(dbg + 4, 1u); const int pc = __popcll(m); if (pc >= 48) atomicAdd(dbg + 6, 1u); else if (pc <= 8) atomicAdd(dbg + 7, 1u); else atomicAdd(dbg + 8, 1u); }
  }
}
__global__ void k_check_emit(Params p) {
  const u32* d = (const u32*)(p.ws + O_DBG);
  const u32 cnt = d[4];
  const int bits1 = (cnt > 0) + 2 * (cnt > 3) + 4 * (cnt > 10) + 8 * (cnt > 30) + 16 * (cnt > 100) + 32 * (cnt > 1000);
  const int bits2 = (d[6] > 0) + 2 * (d[7] > 0) + 4 * (d[8] > 0) + 8 * (d[6] > d[7] + d[8]);
  const float c1 = (float)(10 + bits1), c2 = (float)(10 + bits2);
  const float v1 = c1 * 1e5f, v2 = c2 * 1e4f;
  for (int i = blockIdx.x * blockDim.x + fresh_tid(); i <= 1000000; i += gridDim.x * blockDim.x) p.out[i] = i == 0 ? v1 : v2;
}
#endif

#if DEBUG_MODE == 4
__global__ void k_check_sel(Params p) {
  const int tid = threadIdx.x;
  const u16* QI = (const u16*)(p.ws + O_QI); const u16* KI = (const u16*)(p.ws + O_KI); const float* WI = (const float*)(p.ws + O_WI);
  const u16* SEL = (const u16*)(p.ws + O_SEL); const int* SELCNT = (const int*)(p.ws + O_SELCNT);
  u32* dbg = (u32*)(p.ws + O_DBG);
  float* scr = (float*)(p.ws + O_LOGITS) + (size_t)blockIdx.x * 8192;
  __shared__ int s_bad;
  for (int sidx = blockIdx.x; sidx < 1024; sidx += gridDim.x) {
    const int b = sidx & 3, t = ((int)(((long long)(sidx >> 2) * 8191) / 255) & ~7) + DBG_TMOD, tok = b * S_ + t;
    if (tid == 0) s_bad = 0;
    __syncthreads();
    for (int k = tid; k <= t; k += blockDim.x) {
      float sc = 0.f;
      for (int h = 0; h < 8; ++h) {
        float d = 0.f;
        for (int e = 0; e < 64; ++e) d += bf2f(QI[(size_t)tok * 512 + h * 64 + e]) * bf2f(KI[(size_t)(b * S_ + k) * 64 + e]);
        sc += WI[tok * 8 + h] * fmaxf(d, 0.f);
      }
      scr[k] = sc;
    }
    __syncthreads();
    const int cnt = SELCNT[tok], want = min(t + 1, NSEL);
    int bad = 0;
    if (tid == 0 && cnt != want) atomicAdd(dbg + 6, 1u);
    if (tid < cnt && tid < NSEL) {
      const int key = SEL[(size_t)tok * NSEL + tid];
      if (key > t) bad += 1;
      else {
        const float sk = scr[key]; int rank = 0;
        for (int k = 0; k <= t; ++k) rank += (scr[k] > sk || (scr[k] == sk && k < key)) ? 1 : 0;
        if (rank >= NSEL + 2) { bad += 1; atomicMax(dbg + 7, (u32)rank); }
        for (int j = 0; j < tid; ++j) if (SEL[(size_t)tok * NSEL + j] == key) { bad += 1; break; }
      }
    }
    if (bad) atomicAdd(&s_bad, bad);
    __syncthreads();
    if (tid == 0 && s_bad) { atomicAdd(dbg + 4, (u32)s_bad); atomicAdd(dbg + 5, 1u); }
    __syncthreads();
  }
}
__device__ float dbg_enc2(float x, float base) { return base * (1.f + 9.f * fminf(1.f, log2f(1.f + x) / 20.f)); }
__global__ void k_check_emit4(Params p) {
  const u32* d = (const u32*)(p.ws + O_DBG);
  const float v1 = dbg_enc2((float)d[7], 1e6f), v2 = dbg_enc2((float)d[4], 1e5f);
  for (int i = blockIdx.x * blockDim.x + threadIdx.x; i < NTOK * 1024; i += gridDim.x * blockDim.x) p.out[i] = i == 0 ? v1 : (i <= 1000000 ? v2 : 0.f);
}
#endif
extern "C" void kernel_launch(void* const* d_in, const int* in_sizes, int n_in, void* d_out, int out_size, void* d_ws, size_t ws_size,
                              hipStream_t stream) {
  Params p{};
  p.x = (const float*)d_in[0]; p.c = (const float*)d_in[1]; p.pos = (const int*)d_in[2];
  p.w_ada = (const float*)d_in[3]; p.b_ada = (const float*)d_in[4]; p.g_mix = (const float*)d_in[5]; p.w_in = (const float*)d_in[6];
  p.qna = (const float*)d_in[7]; p.kna = (const float*)d_in[8]; p.qnb = (const float*)d_in[9]; p.knb = (const float*)d_in[10];
  p.w_out = (const float*)d_in[11]; p.g_ffn = (const float*)d_in[12]; p.w_router = (const float*)d_in[13]; p.rbias = (const float*)d_in[14];
  p.w_gate = (const float*)d_in[15]; p.w_up = (const float*)d_in[16]; p.w_down = (const float*)d_in[17];
  p.ws_gate = (const float*)d_in[18]; p.ws_up = (const float*)d_in[19]; p.ws_down = (const float*)d_in[20];
  p.out = (float*)d_out; p.ws = (char*)d_ws;
  if (ws_size < WS_TOTAL) { fprintf(stderr, "workspace too small: %zu < %zu\n", ws_size, (size_t)WS_TOTAL); return; }
  (void)hipMemsetAsync(d_ws, 0, ZERO_BYTES, stream);
#if MEGA && DEBUG_MODE != 4 && DEBUG_MODE != 5
  static int grid_blocks = 0;
  if (!grid_blocks) {
    int dev = 0, cus = 0, per_cu = 0;
    (void)hipGetDevice(&dev);
    (void)hipDeviceGetAttribute(&cus, hipDeviceAttributeMultiprocessorCount, dev);
    (void)hipOccupancyMaxActiveBlocksPerMultiprocessor(&per_cu, k_mega, THREADS, 0);
    if (per_cu > 2) per_cu = 2;
    grid_blocks = cus * per_cu;
    grid_blocks -= grid_blocks % 8;
  }
  void* args[] = {&p};
  hipError_t e = hipLaunchCooperativeKernel((void*)k_mega, dim3(grid_blocks), dim3(THREADS), args, 0, stream);
  if (e != hipSuccess) fprintf(stderr, "cooperative launch failed: %s (grid %d)\n", hipGetErrorString(e), grid_blocks);
#else
  const dim3 g(2048), t(THREADS);
  k_prep<<<g, t, 0, stream>>>(p);
  k_norm1<<<g, t, 0, stream>>>(p);
  k_proj<<<g, t, 0, stream>>>(p);
  k_indexer<<<dim3(1024), t, 0, stream>>>(p);
#if DEBUG_MODE == 4
  k_check_sel<<<512, 256, 0, stream>>>(p); k_check_emit4<<<256, 256, 0, stream>>>(p); return;
#endif
  k_dilated<<<g, t, 0, stream>>>(p);
  k_sparse<<<g, t, 0, stream>>>(p);
  k_dilcomb<<<g, t, 0, stream>>>(p);
  k_outproj<<<g, t, 0, stream>>>(p);
  k_norm2<<<g, t, 0, stream>>>(p);
  k_router<<<g, t, 0, stream>>>(p);
  k_route<<<g, t, 0, stream>>>(p);
  k_dispatch<<<g, t, 0, stream>>>(p);
  k_moeup<<<g, t, 0, stream>>>(p);
  k_moedown<<<g, t, 0, stream>>>(p);
  k_combine<<<g, t, 0, stream>>>(p);
#endif
}
```
